# Optimizing an MI355X kernel written in HIP

```python
import jax, jax.numpy as jnp
from jax import lax
import numpy as np

D_MODEL = 1024
BATCH = 2
SEQ = 8192
DEPTH = 4

N_MEM = 256
D_FF = 2816
N_BRANCH = 3
NORM_EPS = 1e-6
MLA_HEADS = 8
MLA_NOPE = 64
MLA_ROPE = 32
MLA_V = 64
MLA_Q_RANK = 256
MLA_KV_RANK = 128
ROPE_THETA = 10000.0
Q_BLOCK = 128
MLA_W = MLA_HEADS * MLA_V
GLA_HEADS = 4
GLA_DK = 64
GLA_DV = 128
GLA_GATE_RANK = 16
GLA_GATE_NORM = 16.0
GLA_CHUNK = 64
GLA_W = GLA_HEADS * GLA_DV
RWKV_HEADS = 8
RWKV_N = 64
RWKV_DECAY_RANK = 64
RWKV_ICLR_RANK = 64
RWKV_GATE_RANK = 160
RWKV_GN_EPS = 64e-5
RWKV_W = RWKV_HEADS * RWKV_N
RWKV_COLS = 3 * RWKV_W + RWKV_DECAY_RANK + RWKV_ICLR_RANK + RWKV_GATE_RANK
MEM_HEADS = 4
MEM_HD = D_MODEL // MEM_HEADS
IN_SPLITS = (MLA_Q_RANK, MLA_KV_RANK, MLA_ROPE,
             GLA_HEADS * GLA_DK, GLA_HEADS * GLA_DK, GLA_W, GLA_W, GLA_GATE_RANK,
             RWKV_COLS, N_BRANCH * D_MODEL)
D_IN = sum(IN_SPLITS)
BRANCH_W = MLA_W + GLA_W + RWKV_W

kernel_name = "hybrid_mla_gla_rwkv7_gated_trunk"


def _offsets(sizes):
    out, acc = [], 0
    for s in sizes[:-1]:
        acc += s
        out.append(acc)
    return out


def _rmsnorm(x, g, eps=NORM_EPS):
    xf = x.astype(jnp.float32)
    y = xf * lax.rsqrt(jnp.mean(xf * xf, axis=-1, keepdims=True) + eps)
    return y.astype(x.dtype) * g


def _rope(t, cos, sin):
    t1, t2 = jnp.split(t, 2, axis=-1)
    return jnp.concatenate([t1 * cos - t2 * sin, t1 * sin + t2 * cos], axis=-1).astype(t.dtype)


def _swiglu(h, w_in, w_out):
    g, u = jnp.split(h @ w_in, 2, axis=-1)
    return (jax.nn.silu(g) * u) @ w_out


def _mla_branch(c_q, c_kv, k_rope_raw, q_norm, w_uq, kv_norm, w_ukv, cos, sin):
    B, S, _ = c_q.shape
    H = MLA_HEADS
    q = (_rmsnorm(c_q, q_norm) @ w_uq).reshape(B, S, H, MLA_NOPE + MLA_ROPE)
    q_nope = q[..., :MLA_NOPE]
    q_rot = _rope(q[..., MLA_NOPE:], cos[:, :, None, :], sin[:, :, None, :])
    kv = (_rmsnorm(c_kv, kv_norm) @ w_ukv).reshape(B, S, H, MLA_NOPE + MLA_V)
    k_nope, v = kv[..., :MLA_NOPE], kv[..., MLA_NOPE:]
    k_rot = _rope(k_rope_raw, cos, sin)
    scale = (MLA_NOPE + MLA_ROPE) ** -0.5
    nb = S // Q_BLOCK
    qn_b = q_nope.reshape(B, nb, Q_BLOCK, H, MLA_NOPE).swapaxes(0, 1)
    qr_b = q_rot.reshape(B, nb, Q_BLOCK, H, MLA_ROPE).swapaxes(0, 1)
    k_pos = jnp.arange(S)

    def block(args):
        qn, qr, blk = args
        s = (jnp.einsum('bqhd,bkhd->bhqk', qn, k_nope)
             + jnp.einsum('bqhr,bkr->bhqk', qr, k_rot)).astype(jnp.float32) * scale
        q_pos = blk * Q_BLOCK + jnp.arange(Q_BLOCK)
        s = jnp.where(k_pos[None, :] <= q_pos[:, None], s, -1e30)
        p = jax.nn.softmax(s, axis=-1).astype(v.dtype)
        return jnp.einsum('bhqk,bkhd->bqhd', p, v)

    o = lax.map(block, (qn_b, qr_b, jnp.arange(nb)))
    return o.swapaxes(0, 1).reshape(B, S, MLA_W)


def _gla_branch(q, k, v, g, a_lr, w_alpha, b_alpha, norm_g):
    B, S, _ = q.shape
    H, C = GLA_HEADS, GLA_CHUNK
    nc = S // C
    q = q.reshape(B, S, H, GLA_DK) * GLA_DK ** -0.5
    k = k.reshape(B, S, H, GLA_DK)
    v = v.reshape(B, S, H, GLA_DV)
    log_a = (jax.nn.log_sigmoid((a_lr @ w_alpha + b_alpha).astype(jnp.float32))
             / GLA_GATE_NORM).reshape(B, S, H, GLA_DK)

    def to_chunks(t):
        return t.reshape(B, nc, C, H, t.shape[-1]).transpose(1, 0, 3, 2, 4)

    causal = jnp.tril(jnp.ones((C, C), dtype=bool))[:, :, None]

    def step(state, inp):
        qc, kc, vc, lac = inp
        b = jnp.cumsum(lac, axis=2)
        b_last = b[:, :, -1:, :]
        diff = b[:, :, :, None, :] - b[:, :, None, :, :]
        decay = jnp.exp(jnp.where(causal, diff, -jnp.inf))
        attn = jnp.einsum('bhid,bhjd,bhijd->bhij', qc, kc, decay)
        o = (jnp.einsum('bhij,bhjv->bhiv', attn, vc)
             + jnp.einsum('bhid,bhdv->bhiv', qc * jnp.exp(b), state))
        state = (state * jnp.exp(b_last)[:, :, 0, :, None]
                 + jnp.einsum('bhjd,bhjv->bhdv', kc * jnp.exp(b_last - b), vc))
        return state, o

    s0 = jnp.zeros((B, H, GLA_DK, GLA_DV), jnp.float32)
    _, o = lax.scan(step, s0, (to_chunks(q), to_chunks(k), to_chunks(v), to_chunks(log_a)))
    o = o.transpose(1, 0, 3, 2, 4).reshape(B, S, H, GLA_DV).astype(v.dtype)
    o = _rmsnorm(o, norm_g).reshape(B, S, GLA_W)
    return o * jax.nn.silu(g)


def _rwkv_branch(z, mu, w0, w_decay, a0, w_iclr, w_gate, k_k, k_a, r_k, ln_w, ln_b):
    B, S, _ = z.shape
    H, N = RWKV_HEADS, RWKV_N
    z_prev = jnp.pad(z, ((0, 0), (1, 0), (0, 0)))[:, :-1]
    z = z + mu * (z_prev - z)
    r, k, v, xw, xa, xg = jnp.split(
        z, _offsets((RWKV_W, RWKV_W, RWKV_W, RWKV_DECAY_RANK, RWKV_ICLR_RANK, RWKV_GATE_RANK)), axis=-1)
    w_log = -jax.nn.softplus(-(w0 + jnp.tanh(xw) @ w_decay).astype(jnp.float32)) - 0.5
    decay = jnp.exp(-jnp.exp(w_log))
    a = jax.nn.sigmoid(a0 + xa @ w_iclr)
    g = jax.nn.sigmoid(xg) @ w_gate
    heads = lambda t: t.reshape(B, S, H, N)
    kk = heads(k * k_k).astype(jnp.float32)
    kk = kk / jnp.maximum(jnp.linalg.norm(kk, axis=-1, keepdims=True), 1e-12)
    k = k * (1 + (a - 1) * k_a)
    r_h, k_h, v_h, a_h, w_h = heads(r), heads(k), heads(v), heads(a), heads(decay)
    seq_major = lambda t: jnp.moveaxis(t.astype(jnp.float32), 1, 0)

    def step(state, inp):
        r_t, w_t, k_t, v_t, kk_t, a_t = inp
        sa = jnp.einsum('bhij,bhj->bhi', state, kk_t)
        state = (state * w_t[:, :, None, :]
                 - sa[..., None] * (kk_t * a_t)[:, :, None, :]
                 + v_t[..., None] * k_t[:, :, None, :])
        return state, jnp.einsum('bhij,bhj->bhi', state, r_t)

    s0 = jnp.zeros((B, H, N, N), jnp.float32)
    _, y = lax.scan(step, s0, (seq_major(r_h), seq_major(w_h), seq_major(k_h),
                               seq_major(v_h), seq_major(kk), seq_major(a_h)))
    y = jnp.moveaxis(y, 0, 1)
    mean = jnp.mean(y, axis=-1, keepdims=True)
    var = jnp.mean(jnp.square(y - mean), axis=-1, keepdims=True)
    yn = ((y - mean) * lax.rsqrt(var + RWKV_GN_EPS)).reshape(B, S, RWKV_W).astype(z.dtype) * ln_w + ln_b
    bonus = jnp.sum(r_h * k_h * r_k.reshape(H, N), axis=-1, keepdims=True) * v_h
    return (yn + bonus.reshape(B, S, RWKV_W)) * g


def _mixer_block(h, cos, sin, w_in, mla_q_norm, mla_w_uq, mla_kv_norm, mla_w_ukv,
                 gla_w_alpha, gla_b_alpha, gla_norm,
                 rwkv_mu, rwkv_w0, rwkv_w_decay, rwkv_a0, rwkv_w_iclr, rwkv_w_gate,
                 rwkv_k_k, rwkv_k_a, rwkv_r_k, rwkv_ln_w, rwkv_ln_b, w_branch, w_out):
    B, S, _ = h.shape
    (c_q, c_kv, k_rope, gla_q, gla_k, gla_v, gla_g, gla_a, rwkv_z, gate_logits) = jnp.split(
        h @ w_in, _offsets(IN_SPLITS), axis=-1)
    o_a = _mla_branch(c_q, c_kv, k_rope, mla_q_norm, mla_w_uq, mla_kv_norm, mla_w_ukv, cos, sin)
    o_b = _gla_branch(gla_q, gla_k, gla_v, gla_g, gla_a, gla_w_alpha, gla_b_alpha, gla_norm)
    o_c = _rwkv_branch(rwkv_z, rwkv_mu, rwkv_w0, rwkv_w_decay, rwkv_a0, rwkv_w_iclr, rwkv_w_gate,
                       rwkv_k_k, rwkv_k_a, rwkv_r_k, rwkv_ln_w, rwkv_ln_b)
    y_a = o_a @ w_branch[:MLA_W]
    y_b = o_b @ w_branch[MLA_W:MLA_W + GLA_W]
    y_c = o_c @ w_branch[MLA_W + GLA_W:]
    gates = jax.nn.sigmoid(gate_logits).reshape(B, S, N_BRANCH, D_MODEL)
    merged = gates[:, :, 0] * y_a + gates[:, :, 1] * y_b + gates[:, :, 2] * y_c
    return merged @ w_out


def _mem_attn(h, mem_n, wq, wkv, wo):
    B, S, _ = h.shape
    q = (h @ wq).reshape(B, S, MEM_HEADS, MEM_HD)
    kv = (mem_n @ wkv).reshape(B, mem_n.shape[1], 2, MEM_HEADS, MEM_HD)
    k, v = kv[:, :, 0], kv[:, :, 1]
    s = jnp.einsum('bqhd,bkhd->bhqk', q, k).astype(jnp.float32) * MEM_HD ** -0.5
    p = jax.nn.softmax(s, axis=-1).astype(v.dtype)
    return jnp.einsum('bhqk,bkhd->bqhd', p, v).reshape(B, S, D_MODEL) @ wo


def setup_inputs(seed: int = 0) -> dict:
    key = jax.random.key(seed)
    ks = iter(jax.random.split(key, 48))
    f32 = jnp.float32
    L = DEPTH

    def nrm(shape, fan_in, s=1.0):
        return jax.random.normal(next(ks), shape, f32) * (s * fan_in ** -0.5)

    def gain(shape):
        return 1.0 + 0.05 * jax.random.normal(next(ks), shape, f32)

    def small(shape, s):
        return s * jax.random.normal(next(ks), shape, f32)

    def unif(shape, lo, hi):
        return jax.random.uniform(next(ks), shape, f32, lo, hi)

    x = jax.random.normal(next(ks), (BATCH, SEQ, D_MODEL), f32)
    mem = jax.random.normal(next(ks), (BATCH, N_MEM, D_MODEL), f32)
    start = jax.random.randint(next(ks), (BATCH, 1), 0, 4096, dtype=jnp.int32)
    positions = start + jnp.arange(SEQ, dtype=jnp.int32)[None, :]
    return {
        "x": x,
        "mem": mem,
        "positions": positions,
        "norm_g": gain((L, 8, D_MODEL)),
        "w_ffn_in": nrm((L, 2, D_MODEL, 2 * D_FF), D_MODEL),
        "w_ffn_out": nrm((L, 2, D_FF, D_MODEL), D_FF),
        "w_in": nrm((L, D_MODEL, D_IN), D_MODEL),
        "mla_q_norm": gain((L, MLA_Q_RANK)),
        "mla_w_uq": nrm((L, MLA_Q_RANK, MLA_HEADS * (MLA_NOPE + MLA_ROPE)), MLA_Q_RANK),
        "mla_kv_norm": gain((L, MLA_KV_RANK)),
        "mla_w_ukv": nrm((L, MLA_KV_RANK, MLA_HEADS * (MLA_NOPE + MLA_V)), MLA_KV_RANK),
        "gla_w_alpha": nrm((L, GLA_GATE_RANK, GLA_HEADS * GLA_DK), GLA_GATE_RANK),
        "gla_b_alpha": unif((L, GLA_HEADS * GLA_DK), -1.0, 4.0),
        "gla_norm": gain((L, GLA_DV)),
        "rwkv_mu": unif((L, RWKV_COLS), 0.0, 1.0),
        "rwkv_w0": unif((L, RWKV_W), -4.0, 0.0),
        "rwkv_w_decay": nrm((L, RWKV_DECAY_RANK, RWKV_W), RWKV_DECAY_RANK, 0.5),
        "rwkv_a0": small((L, RWKV_W), 0.1),
        "rwkv_w_iclr": nrm((L, RWKV_ICLR_RANK, RWKV_W), RWKV_ICLR_RANK, 0.5),
        "rwkv_w_gate": nrm((L, RWKV_GATE_RANK, RWKV_W), RWKV_GATE_RANK),
        "rwkv_k_k": 0.85 + small((L, RWKV_W), 0.1),
        "rwkv_k_a": gain((L, RWKV_W)),
        "rwkv_r_k": small((L, RWKV_W), 0.1),
        "rwkv_ln_w": gain((L, RWKV_W)),
        "rwkv_ln_b": small((L, RWKV_W), 0.02),
        "w_branch": nrm((L, BRANCH_W, D_MODEL), RWKV_W),
        "w_out": nrm((L, D_MODEL, D_MODEL), D_MODEL),
        "mem_norm": gain((L, D_MODEL)),
        "mem_wq": nrm((L, D_MODEL, D_MODEL), D_MODEL),
        "mem_wkv": nrm((L, D_MODEL, 2 * D_MODEL), D_MODEL),
        "mem_wo": nrm((L, D_MODEL, D_MODEL), D_MODEL),
    }


def reference(x, mem, positions, norm_g, w_ffn_in, w_ffn_out, w_in,
              mla_q_norm, mla_w_uq, mla_kv_norm, mla_w_ukv,
              gla_w_alpha, gla_b_alpha, gla_norm,
              rwkv_mu, rwkv_w0, rwkv_w_decay, rwkv_a0, rwkv_w_iclr, rwkv_w_gate,
              rwkv_k_k, rwkv_k_a, rwkv_r_k, rwkv_ln_w, rwkv_ln_b,
              w_branch, w_out, mem_norm, mem_wq, mem_wkv, mem_wo):
    inv_freq = ROPE_THETA ** (-jnp.arange(0, MLA_ROPE, 2, dtype=jnp.float32) / MLA_ROPE)
    ang = positions.astype(jnp.float32)[..., None] * inv_freq
    cos, sin = jnp.cos(ang), jnp.sin(ang)
    for l in range(DEPTH):
        ng = norm_g[l]
        x = x + 0.5 * _rmsnorm(_swiglu(_rmsnorm(x, ng[0]), w_ffn_in[l, 0], w_ffn_out[l, 0]), ng[1])
        y = _mixer_block(_rmsnorm(x, ng[2]), cos, sin, w_in[l],
                         mla_q_norm[l], mla_w_uq[l], mla_kv_norm[l], mla_w_ukv[l],
                         gla_w_alpha[l], gla_b_alpha[l], gla_norm[l],
                         rwkv_mu[l], rwkv_w0[l], rwkv_w_decay[l], rwkv_a0[l], rwkv_w_iclr[l],
                         rwkv_w_gate[l], rwkv_k_k[l], rwkv_k_a[l], rwkv_r_k[l],
                         rwkv_ln_w[l], rwkv_ln_b[l], w_branch[l], w_out[l])
        x = x + _rmsnorm(y, ng[3])
        y = _mem_attn(_rmsnorm(x, ng[4]), _rmsnorm(mem, mem_norm[l]), mem_wq[l], mem_wkv[l], mem_wo[l])
        x = x + _rmsnorm(y, ng[5])
        x = x + 0.5 * _rmsnorm(_swiglu(_rmsnorm(x, ng[6]), w_ffn_in[l, 1], w_ffn_out[l, 1]), ng[7])
    return x
```

```cpp
#include <hip/hip_runtime.h>
#include <cstdio>
#include <cstdint>
namespace nv {
constexpr int S = 8192, D = 1024, DFF = 2816, DIN = 6864, NMEM = 256;
constexpr float EPS = 1e-6f;

__device__ __forceinline__ float wsum(float v) {
#pragma unroll
    for (int o = 32; o > 0; o >>= 1) v += __shfl_xor(v, o);
    return v;
}
__device__ __forceinline__ float wmax(float v) {
#pragma unroll
    for (int o = 32; o > 0; o >>= 1) v = fmaxf(v, __shfl_xor(v, o));
    return v;
}
__device__ __forceinline__ float sigmoidf_(float x) { return 1.f / (1.f + expf(-x)); }
__device__ __forceinline__ float logsigmoidf_(float x) { return fminf(x, 0.f) - log1pf(expf(-fabsf(x))); }
__device__ __forceinline__ float softplusf_(float x) { return fmaxf(x, 0.f) + log1pf(expf(-fabsf(x))); }

__global__ void k_rmsnorm(const float* in, int ldi, const float* g, float* out, int ldo, int Dn, float eps) {
    const int row = blockIdx.x, lane = threadIdx.x;
    const float* r = in + (size_t)row * ldi;
    float s = 0.f;
    for (int c = lane; c < Dn; c += 64) s += r[c] * r[c];
    s = wsum(s);
    const float rs = rsqrtf(s / Dn + eps);
    for (int c = lane; c < Dn; c += 64) out[(size_t)row * ldo + c] = r[c] * rs * g[c];
}
__global__ void k_resid(float* x, const float* y, const float* g, float alpha, int Dn, float eps) {
    const int row = blockIdx.x, lane = threadIdx.x;
    const float* r = y + (size_t)row * Dn;
    float s = 0.f;
    for (int c = lane; c < Dn; c += 64) s += r[c] * r[c];
    s = wsum(s);
    const float rs = rsqrtf(s / Dn + eps);
    for (int c = lane; c < Dn; c += 64) x[(size_t)row * Dn + c] += alpha * r[c] * rs * g[c];
}
__global__ void __launch_bounds__(256) k_gemm(const float* __restrict__ A, int lda, const float* __restrict__ B, int ldb, float* __restrict__ C, int ldc, int M, int N, int K) {
    __shared__ float As[8][128 + 4];
    __shared__ float Bs[8][128 + 4];
    const int tid = threadIdx.x, tx = tid & 15, ty = tid >> 4;
    const int m0 = blockIdx.y * 128, n0 = blockIdx.x * 128;
    float acc[8][8];
#pragma unroll
    for (int i = 0; i < 8; ++i)
#pragma unroll
        for (int j = 0; j < 8; ++j) acc[i][j] = 0.f;
    const int ar = tid >> 1, ak = (tid & 1) * 4;
    const int bk = tid >> 5, bn = (tid & 31) * 4;
    for (int k0 = 0; k0 < K; k0 += 8) {
        const float4 av = *(const float4*)(A + (size_t)(m0 + ar) * lda + k0 + ak);
        float4 bv = make_float4(0.f, 0.f, 0.f, 0.f);
        if (n0 + bn < N) bv = *(const float4*)(B + (size_t)(k0 + bk) * ldb + n0 + bn);
        __syncthreads();
        As[ak + 0][ar] = av.x; As[ak + 1][ar] = av.y; As[ak + 2][ar] = av.z; As[ak + 3][ar] = av.w;
        *(float4*)&Bs[bk][bn] = bv;
        __syncthreads();
#pragma unroll
        for (int kk = 0; kk < 8; ++kk) {
            float a[8], b[8];
#pragma unroll
            for (int i = 0; i < 8; ++i) a[i] = As[kk][ty * 8 + i];
#pragma unroll
            for (int j = 0; j < 8; ++j) b[j] = Bs[kk][tx * 8 + j];
#pragma unroll
            for (int i = 0; i < 8; ++i)
#pragma unroll
                for (int j = 0; j < 8; ++j) acc[i][j] += a[i] * b[j];
        }
    }
#pragma unroll
    for (int i = 0; i < 8; ++i) {
        const int r = m0 + ty * 8 + i;
#pragma unroll
        for (int j = 0; j < 8; ++j) { const int c = n0 + tx * 8 + j; if (c < N) C[(size_t)r * ldc + c] = acc[i][j]; }
    }
}
__global__ void k_swiglu(const float* hh, float* h, int rows) {
    const size_t i = (size_t)blockIdx.x * 256 + threadIdx.x;
    if (i >= (size_t)rows * DFF) return;
    const size_t r = i / DFF, c = i % DFF;
    const float g = hh[r * (2 * DFF) + c], u = hh[r * (2 * DFF) + DFF + c];
    h[i] = g * sigmoidf_(g) * u;
}
__device__ __forceinline__ void rope_cs(int pos, int i, float& c, float& s) {
    const double inv = exp2(-(double)i * (13.287712379549449 / 16.0));
    const double ang = (double)pos * inv;
    c = (float)cos(ang); s = (float)sin(ang);
}
__global__ void k_rope_q(float* q, const int* pos, int rows) {
    const int idx = blockIdx.x * 256 + threadIdx.x;
    if (idx >= rows * 8 * 16) return;
    const int i = idx & 15, h = (idx >> 4) & 7, r = idx >> 7;
    float c, s; rope_cs(pos[r], i, c, s);
    float* p = q + (size_t)r * 768 + h * 96 + 64;
    const float t1 = p[i], t2 = p[i + 16];
    p[i] = t1 * c - t2 * s; p[i + 16] = t1 * s + t2 * c;
}
__global__ void k_rope_k(const float* Z, float* krot, const int* pos, int rows) {
    const int idx = blockIdx.x * 256 + threadIdx.x;
    if (idx >= rows * 16) return;
    const int i = idx & 15, r = idx >> 4;
    float c, s; rope_cs(pos[r], i, c, s);
    const float* p = Z + (size_t)r * DIN + 384;
    const float t1 = p[i], t2 = p[i + 16];
    krot[r * 32 + i] = t1 * c - t2 * s; krot[r * 32 + i + 16] = t1 * s + t2 * c;
}
__global__ void __launch_bounds__(64) k_mla_attn(const float* __restrict__ q, const float* __restrict__ kv, const float* __restrict__ krot, float* __restrict__ o) {
    const int h = blockIdx.y, qi = blockIdx.x * 64 + threadIdx.x;
    float qr[96], acc[64];
    const float scale = 0.10206207261596577f;
#pragma unroll
    for (int d = 0; d < 96; ++d) qr[d] = q[(size_t)qi * 768 + h * 96 + d] * scale;
#pragma unroll
    for (int d = 0; d < 64; ++d) acc[d] = 0.f;
    float m = -1e30f, l = 0.f;
    const int jmax = blockIdx.x * 64 + 63;
    for (int j = 0; j <= jmax; ++j) {
        const float* kp = kv + (size_t)j * 1024 + h * 128;
        const float* kr = krot + (size_t)j * 32;
        float s = 0.f;
#pragma unroll
        for (int d = 0; d < 64; ++d) s += qr[d] * kp[d];
#pragma unroll
        for (int d = 0; d < 32; ++d) s += qr[64 + d] * kr[d];
        if (j > qi) s = -1e30f;
        const float mn = fmaxf(m, s);
        const float f = expf(m - mn), p = (j > qi) ? 0.f : expf(s - mn);
        l = l * f + p;
#pragma unroll
        for (int d = 0; d < 64; ++d) acc[d] = acc[d] * f + p * kp[64 + d];
        m = mn;
    }
    const float il = 1.f / l;
#pragma unroll
    for (int d = 0; d < 64; ++d) o[(size_t)qi * 512 + h * 64 + d] = acc[d] * il;
}
__global__ void k_gla_la(const float* Z, const float* wa, const float* ba, float* la, int rows) {
    const int idx = blockIdx.x * 256 + threadIdx.x;
    if (idx >= rows * 256) return;
    const int c = idx & 255, r = idx >> 8;
    float s = ba[c];
    for (int k = 0; k < 16; ++k) s += Z[(size_t)r * DIN + 1952 + k] * wa[k * 256 + c];
    la[idx] = logsigmoidf_(s) * (1.f / 16.f);
}
__global__ void __launch_bounds__(128) k_gla_scan(const float* __restrict__ Z, const float* __restrict__ la, float* __restrict__ oraw) {
    const int h = blockIdx.x, v = threadIdx.x;
    __shared__ float sq[64], sk[64], se[64];
    float St[64];
#pragma unroll
    for (int d = 0; d < 64; ++d) St[d] = 0.f;
    float nq = 0.f, nk = 0.f, nl = 0.f, nvv;
    if (v < 64) { nq = Z[416 + h * 64 + v]; nk = Z[672 + h * 64 + v]; nl = la[h * 64 + v]; }
    nvv = Z[928 + h * 128 + v];
    for (int t = 0; t < S; ++t) {
        const float cq = nq, ck = nk, cl = nl, vv = nvv;
        if (t + 1 < S) {
            if (v < 64) { nq = Z[(size_t)(t + 1) * DIN + 416 + h * 64 + v]; nk = Z[(size_t)(t + 1) * DIN + 672 + h * 64 + v]; nl = la[(size_t)(t + 1) * 256 + h * 64 + v]; }
            nvv = Z[(size_t)(t + 1) * DIN + 928 + h * 128 + v];
        }
        __syncthreads();
        if (v < 64) { sq[v] = cq * 0.125f; sk[v] = ck; se[v] = expf(cl); }
        __syncthreads();
        float o = 0.f;
#pragma unroll
        for (int d = 0; d < 64; ++d) { St[d] = St[d] * se[d] + sk[d] * vv; o += sq[d] * St[d]; }
        oraw[(size_t)t * 512 + h * 128 + v] = o;
    }
}
__global__ void k_gla_post(const float* oraw, const float* gn, const float* Z, float* ob) {
    const int r = blockIdx.x >> 2, h = blockIdx.x & 3, lane = threadIdx.x;
    const float a = oraw[(size_t)r * 512 + h * 128 + lane], b = oraw[(size_t)r * 512 + h * 128 + 64 + lane];
    const float rs = rsqrtf(wsum(a * a + b * b) / 128.f + EPS);
    const float g0 = Z[(size_t)r * DIN + 1440 + h * 128 + lane], g1 = Z[(size_t)r * DIN + 1440 + h * 128 + 64 + lane];
    ob[(size_t)r * 512 + h * 128 + lane] = a * rs * gn[lane] * (g0 * sigmoidf_(g0));
    ob[(size_t)r * 512 + h * 128 + 64 + lane] = b * rs * gn[64 + lane] * (g1 * sigmoidf_(g1));
}
__global__ void k_rwkv_lerp(const float* Z, const float* mu, float* zz, int rows) {
    const size_t i = (size_t)blockIdx.x * 256 + threadIdx.x;
    if (i >= (size_t)rows * 1824) return;
    const size_t r = i / 1824, c = i % 1824;
    const float z = Z[r * DIN + 1968 + c], zp = (r == 0) ? 0.f : Z[(r - 1) * DIN + 1968 + c];
    zz[i] = z + mu[c] * (zp - z);
}
__global__ void k_rwkv_act(const float* zz, float* twx, float* sxg, int rows) {
    const int idx = blockIdx.x * 256 + threadIdx.x;
    if (idx >= rows * 224) return;
    const int r = idx / 224, c = idx % 224;
    if (c < 64) twx[r * 64 + c] = tanhf(zz[(size_t)r * 1824 + 1536 + c]);
    else sxg[r * 160 + (c - 64)] = sigmoidf_(zz[(size_t)r * 1824 + 1664 + (c - 64)]);
}
__global__ void __launch_bounds__(64) k_rwkv_scan(const float* __restrict__ zz, const float* __restrict__ wlin, const float* __restrict__ alin,
                                                  const float* __restrict__ w0, const float* __restrict__ a0, const float* __restrict__ kk_, const float* __restrict__ ka_,
                                                  float* __restrict__ yraw, float* __restrict__ kmod_out) {
    const int h = blockIdx.x, i = threadIdx.x, c = h * 64 + i;
    __shared__ float4 sv[64];
    __shared__ float skk[64];
    float St[64];
#pragma unroll
    for (int j = 0; j < 64; ++j) St[j] = 0.f;
    const float w0c = w0[c], a0c = a0[c], kkc = kk_[c], kac = ka_[c];
    float nr = zz[c], nk = zz[512 + c], nv_ = zz[1024 + c], nw = wlin[c], na = alin[c];
    for (int t = 0; t < S; ++t) {
        const float r = nr, k = nk, v = nv_, wl_in = nw, al_in = na;
        if (t + 1 < S) { nr = zz[(size_t)(t + 1) * 1824 + c]; nk = zz[(size_t)(t + 1) * 1824 + 512 + c]; nv_ = zz[(size_t)(t + 1) * 1824 + 1024 + c]; nw = wlin[(size_t)(t + 1) * 512 + c]; na = alin[(size_t)(t + 1) * 512 + c]; }
        const float wl = -softplusf_(-(w0c + wl_in)) - 0.5f;
        const float dec = expf(-expf(wl));
        const float a = sigmoidf_(a0c + al_in);
        float kk = k * kkc;
        const float nrm = sqrtf(wsum(kk * kk));
        kk = kk / fmaxf(nrm, 1e-12f);
        const float km = k * (1.f + (a - 1.f) * kac);
        __syncthreads();
        sv[i] = make_float4(dec, kk * a, km, r); skk[i] = kk;
        kmod_out[(size_t)t * 512 + c] = km;
        __syncthreads();
        float sa = 0.f;
#pragma unroll
        for (int j = 0; j < 64; ++j) sa += St[j] * skk[j];
        float y = 0.f;
#pragma unroll
        for (int j = 0; j < 64; ++j) { const float4 q = sv[j]; St[j] = St[j] * q.x - sa * q.y + v * q.z; y += St[j] * q.w; }
        yraw[(size_t)t * 512 + c] = y;
    }
}
__global__ void k_rwkv_post(const float* yraw, const float* zz, const float* kmod, const float* gg, const float* rk, const float* lw, const float* lb, float* oc) {
    const int r = blockIdx.x >> 3, h = blockIdx.x & 7, lane = threadIdx.x, c = h * 64 + lane;
    const float y = yraw[(size_t)r * 512 + c];
    const float mean = wsum(y) / 64.f;
    const float d = y - mean;
    const float var = wsum(d * d) / 64.f;
    const float yn = d * rsqrtf(var + 64e-5f) * lw[c] + lb[c];
    const float rr = zz[(size_t)r * 1824 + c], vv = zz[(size_t)r * 1824 + 1024 + c];
    const float bonus = wsum(rr * kmod[(size_t)r * 512 + c] * rk[c]) * vv;
    oc[(size_t)r * 512 + c] = (yn + bonus) * gg[(size_t)r * 512 + c];
}
__global__ void k_merge(const float* Z, const float* y, float* merged, int bi, int rows) {
    const size_t i = (size_t)blockIdx.x * 256 + threadIdx.x;
    if (i >= (size_t)rows * 1024) return;
    const size_t r = i >> 10, c = i & 1023;
    const float g = sigmoidf_(Z[r * DIN + 3792 + bi * 1024 + c]);
    merged[i] = (bi == 0 ? 0.f : merged[i]) + g * y[i];
}
__global__ void __launch_bounds__(256) k_memattn(const float* __restrict__ q, const float* __restrict__ kvm, float* __restrict__ o) {
    const int r = blockIdx.x >> 2, h = blockIdx.x & 3, t = threadIdx.x;
    __shared__ float sq[256], sp[256], red[8];
    sq[t] = q[(size_t)r * 1024 + h * 256 + t];
    __syncthreads();
    float s = 0.f;
    const float* kp = kvm + (size_t)t * 2048 + h * 256;
    for (int d = 0; d < 256; ++d) s += sq[d] * kp[d];
    s *= 0.0625f;
    float m = wmax(s);
    if ((t & 63) == 0) red[t >> 6] = m;
    __syncthreads();
    m = fmaxf(fmaxf(red[0], red[1]), fmaxf(red[2], red[3]));
    const float p = expf(s - m);
    float l = wsum(p);
    if ((t & 63) == 0) red[4 + (t >> 6)] = l;
    sp[t] = p;
    __syncthreads();
    l = red[4] + red[5] + red[6] + red[7];
    float acc = 0.f;
    for (int k = 0; k < 256; ++k) acc += sp[k] * kvm[(size_t)k * 2048 + 1024 + h * 256 + t];
    o[(size_t)r * 1024 + h * 256 + t] = acc / l;
}

struct Bufs { float *R1, *R2, *xn, *y; };
inline void gemm(hipStream_t st, const float* A, int lda, const float* B, int ldb, float* C, int ldc, int M, int N, int K) {
    dim3 g((N + 127) / 128, M / 128);
    hipLaunchKernelGGL(k_gemm, g, dim3(256), 0, st, A, lda, B, ldb, C, ldc, M, N, K);
}
inline int cdiv(size_t a, size_t b) { return (int)((a + b - 1) / b); }

inline void forward(void* const* d_in, float* xall, float* ws, hipStream_t st) {
    const float* mem = (const float*)d_in[1]; const int* pos_all = (const int*)d_in[2];
    const float* norm_g = (const float*)d_in[3]; const float* w_ffn_in = (const float*)d_in[4]; const float* w_ffn_out = (const float*)d_in[5];
    const float* w_in = (const float*)d_in[6]; const float* mla_q_norm = (const float*)d_in[7]; const float* mla_w_uq = (const float*)d_in[8];
    const float* mla_kv_norm = (const float*)d_in[9]; const float* mla_w_ukv = (const float*)d_in[10]; const float* gla_w_alpha = (const float*)d_in[11];
    const float* gla_b_alpha = (const float*)d_in[12]; const float* gla_norm = (const float*)d_in[13]; const float* rwkv_mu = (const float*)d_in[14];
    const float* rwkv_w0 = (const float*)d_in[15]; const float* rwkv_w_decay = (const float*)d_in[16]; const float* rwkv_a0 = (const float*)d_in[17];
    const float* rwkv_w_iclr = (const float*)d_in[18]; const float* rwkv_w_gate = (const float*)d_in[19]; const float* rwkv_k_k = (const float*)d_in[20];
    const float* rwkv_k_a = (const float*)d_in[21]; const float* rwkv_r_k = (const float*)d_in[22]; const float* rwkv_ln_w = (const float*)d_in[23];
    const float* rwkv_ln_b = (const float*)d_in[24]; const float* w_branch = (const float*)d_in[25]; const float* w_out = (const float*)d_in[26];
    const float* mem_norm = (const float*)d_in[27]; const float* mem_wq = (const float*)d_in[28]; const float* mem_wkv = (const float*)d_in[29]; const float* mem_wo = (const float*)d_in[30];
    float* p = ws;
    float* R1 = p; p += (size_t)S * DIN;
    float* xn = p; p += (size_t)S * D;
    float* y = p;  p += (size_t)S * D;
    float* R2 = p;
    float* hb = R2;
    float* q_ = R2; float* cqn = q_ + (size_t)S * 768; float* ckvn = cqn + (size_t)S * 256; float* kv = ckvn + (size_t)S * 128; float* krot = kv + (size_t)S * 1024;
    float* oa = krot + (size_t)S * 32; float* la = oa + (size_t)S * 512; float* oraw = la + (size_t)S * 256; float* ob = oraw + (size_t)S * 512;
    float* zz = ob + (size_t)S * 512; float* twx = zz + (size_t)S * 1824; float* sxg = twx + (size_t)S * 64; float* wlin = sxg + (size_t)S * 160;
    float* alin = wlin + (size_t)S * 512; float* gg = alin + (size_t)S * 512; float* yraw = gg + (size_t)S * 512; float* kmod = yraw + (size_t)S * 512;
    float* oc = kmod + (size_t)S * 512; float* ytmp = oc + (size_t)S * 512; float* merged = ytmp + (size_t)S * 1024;
    float* mq = R2; float* mo = mq + (size_t)S * 1024; float* memn = merged + (size_t)S * 1024; float* kvm = memn + (size_t)NMEM * 1024;
    for (int b = 0; b < 2; ++b) {
        float* x = xall + (size_t)b * S * D; const int* pos = pos_all + b * S;
        for (int l = 0; l < 4; ++l) {
            const float* ng = norm_g + (size_t)l * 8 * D;
            for (int f = 0; f < 2; ++f) {
                if (f == 1) {
                    hipLaunchKernelGGL(k_rmsnorm, dim3(S), dim3(64), 0, st, x, D, ng + 2 * D, xn, D, D, EPS);
                    float* Z = R1;
                    gemm(st, xn, D, w_in + (size_t)l * D * DIN, DIN, Z, DIN, S, DIN, D);
                    hipLaunchKernelGGL(k_rmsnorm, dim3(S), dim3(64), 0, st, Z, DIN, mla_q_norm + l * 256, cqn, 256, 256, EPS);
                    gemm(st, cqn, 256, mla_w_uq + (size_t)l * 256 * 768, 768, q_, 768, S, 768, 256);
                    hipLaunchKernelGGL(k_rmsnorm, dim3(S), dim3(64), 0, st, Z + 256, DIN, mla_kv_norm + l * 128, ckvn, 128, 128, EPS);
                    gemm(st, ckvn, 128, mla_w_ukv + (size_t)l * 128 * 1024, 1024, kv, 1024, S, 1024, 128);
                    hipLaunchKernelGGL(k_rope_q, dim3(cdiv((size_t)S * 128, 256)), dim3(256), 0, st, q_, pos, S);
                    hipLaunchKernelGGL(k_rope_k, dim3(cdiv((size_t)S * 16, 256)), dim3(256), 0, st, Z, krot, pos, S);
                    hipLaunchKernelGGL(k_mla_attn, dim3(S / 64, 8), dim3(64), 0, st, q_, kv, krot, oa);
                    hipLaunchKernelGGL(k_gla_la, dim3(cdiv((size_t)S * 256, 256)), dim3(256), 0, st, Z, gla_w_alpha + l * 16 * 256, gla_b_alpha + l * 256, la, S);
                    hipLaunchKernelGGL(k_gla_scan, dim3(4), dim3(128), 0, st, Z, la, oraw);
                    hipLaunchKernelGGL(k_gla_post, dim3(S * 4), dim3(64), 0, st, oraw, gla_norm + l * 128, Z, ob);
                    hipLaunchKernelGGL(k_rwkv_lerp, dim3(cdiv((size_t)S * 1824, 256)), dim3(256), 0, st, Z, rwkv_mu + l * 1824, zz, S);
                    hipLaunchKernelGGL(k_rwkv_act, dim3(cdiv((size_t)S * 224, 256)), dim3(256), 0, st, zz, twx, sxg, S);
                    gemm(st, twx, 64, rwkv_w_decay + (size_t)l * 64 * 512, 512, wlin, 512, S, 512, 64);
                    gemm(st, zz + 1600, 1824, rwkv_w_iclr + (size_t)l * 64 * 512, 512, alin, 512, S, 512, 64);
                    gemm(st, sxg, 160, rwkv_w_gate + (size_t)l * 160 * 512, 512, gg, 512, S, 512, 160);
                    hipLaunchKernelGGL(k_rwkv_scan, dim3(8), dim3(64), 0, st, zz, wlin, alin, rwkv_w0 + l * 512, rwkv_a0 + l * 512, rwkv_k_k + l * 512, rwkv_k_a + l * 512, yraw, kmod);
                    hipLaunchKernelGGL(k_rwkv_post, dim3(S * 8), dim3(64), 0, st, yraw, zz, kmod, gg, rwkv_r_k + l * 512, rwkv_ln_w + l * 512, rwkv_ln_b + l * 512, oc);
                    const float* wb = w_branch + (size_t)l * 1536 * 1024;
                    gemm(st, oa, 512, wb, 1024, ytmp, 1024, S, 1024, 512);
                    hipLaunchKernelGGL(k_merge, dim3(cdiv((size_t)S * 1024, 256)), dim3(256), 0, st, Z, ytmp, merged, 0, S);
                    gemm(st, ob, 512, wb + (size_t)512 * 1024, 1024, ytmp, 1024, S, 1024, 512);
                    hipLaunchKernelGGL(k_merge, dim3(cdiv((size_t)S * 1024, 256)), dim3(256), 0, st, Z, ytmp, merged, 1, S);
                    gemm(st, oc, 512, wb + (size_t)1024 * 1024, 1024, ytmp, 1024, S, 1024, 512);
                    hipLaunchKernelGGL(k_merge, dim3(cdiv((size_t)S * 1024, 256)), dim3(256), 0, st, Z, ytmp, merged, 2, S);
                    gemm(st, merged, 1024, w_out + (size_t)l * D * D, D, y, D, S, D, D);
                    hipLaunchKernelGGL(k_resid, dim3(S), dim3(64), 0, st, x, y, ng + 3 * D, 1.0f, D, EPS);
                    hipLaunchKernelGGL(k_rmsnorm, dim3(S), dim3(64), 0, st, x, D, ng + 4 * D, xn, D, D, EPS);
                    hipLaunchKernelGGL(k_rmsnorm, dim3(NMEM), dim3(64), 0, st, mem + (size_t)b * NMEM * D, D, mem_norm + l * D, memn, D, D, EPS);
                    gemm(st, xn, D, mem_wq + (size_t)l * D * D, D, mq, D, S, D, D);
                    gemm(st, memn, D, mem_wkv + (size_t)l * D * 2 * D, 2 * D, kvm, 2 * D, NMEM, 2 * D, D);
                    hipLaunchKernelGGL(k_memattn, dim3(S * 4), dim3(256), 0, st, mq, kvm, mo);
                    gemm(st, mo, D, mem_wo + (size_t)l * D * D, D, y, D, S, D, D);
                    hipLaunchKernelGGL(k_resid, dim3(S), dim3(64), 0, st, x, y, ng + 5 * D, 1.0f, D, EPS);
                }
                hipLaunchKernelGGL(k_rmsnorm, dim3(S), dim3(64), 0, st, x, D, ng + (f ? 6 : 0) * D, xn, D, D, EPS);
                gemm(st, xn, D, w_ffn_in + ((size_t)l * 2 + f) * D * 2 * DFF, 2 * DFF, R1, 2 * DFF, S, 2 * DFF, D);
                hipLaunchKernelGGL(k_swiglu, dim3(cdiv((size_t)S * DFF, 256)), dim3(256), 0, st, R1, hb, S);
                gemm(st, hb, DFF, w_ffn_out + ((size_t)l * 2 + f) * DFF * D, D, y, D, S, D, DFF);
                hipLaunchKernelGGL(k_resid, dim3(S), dim3(64), 0, st, x, y, ng + (f ? 7 : 1) * D, 0.5f, D, EPS);
            }
        }
    }
}
}

extern "C" void kernel_launch(void* const* d_in, const int* in_sizes, int n_in, void* d_out, int out_size, void* d_ws, size_t ws_size, hipStream_t stream) {
    (void)in_sizes; (void)n_in; (void)ws_size;
    hipMemcpyAsync(d_out, d_in[0], (size_t)out_size * sizeof(float), hipMemcpyDeviceToDevice, stream);
    nv::forward(d_in, (float*)d_out, (float*)d_ws, stream);
}
```

```cpp
#include <hip/hip_runtime.h>
#include <cstdio>
#include <cstdint>
#include <cmath>
#define GAS __attribute__((address_space(1)))
#define LAS __attribute__((address_space(3)))
typedef unsigned short bf16;
typedef unsigned v4u __attribute__((ext_vector_type(4)));
typedef float f32x4 __attribute__((ext_vector_type(4)));
typedef short bf16x8 __attribute__((ext_vector_type(8)));
typedef GAS unsigned gu32;
typedef GAS unsigned long long gu64;
__device__ __forceinline__ int lt_tid(int w0) { asm volatile("" : "+s"(w0)); int t = (w0 << 6) | (int)__builtin_amdgcn_mbcnt_hi(~0u, __builtin_amdgcn_mbcnt_lo(~0u, 0u)); asm volatile("" : "+v"(t)); return t; }
#define RLX_AGENT __ATOMIC_RELAXED, __HIP_MEMORY_SCOPE_AGENT
#define LDS_WAIT() asm volatile("s_waitcnt lgkmcnt(0)" ::: "memory")
#define VM_WAIT() asm volatile("s_waitcnt vmcnt(0)" ::: "memory")
__device__ __forceinline__ unsigned long long rt() { return __builtin_amdgcn_s_memrealtime(); }
__device__ __forceinline__ unsigned f2bf(float f) { unsigned u = __builtin_bit_cast(unsigned, f); return (u + 0x7fffu + ((u >> 16) & 1u)) >> 16; }
__device__ __forceinline__ unsigned pk2(float lo, float hi) { return f2bf(lo) | (f2bf(hi) << 16); }

#define XB_TMO      128
#define XB_XCNT(j)  (256  + 64 * (j))
#define XB_XSUB(j)  (1280 + 64 * (j))
#define XB_XGEN(j)  (2304 + 64 * (j))
#define XB_TOP      3328
#define XB_TOPGEN   3392
#define XCD_BAR_WORDS 3456
#define XB_SPIN_CAP (1u << 18)

__device__ __forceinline__ unsigned xb_ld(unsigned* p)              { return __hip_atomic_load(p, __ATOMIC_RELAXED, __HIP_MEMORY_SCOPE_AGENT); }
__device__ __forceinline__ unsigned xb_add(unsigned* p, unsigned v) { return __hip_atomic_fetch_add(p, v, __ATOMIC_RELAXED, __HIP_MEMORY_SCOPE_AGENT); }
__device__ __forceinline__ unsigned xb_xcc_id() { return (unsigned)__builtin_amdgcn_s_getreg((3 << 11) | 20) & 0xFu; }
#define XB_SPIN(cond, bar) do { unsigned _sp = 0; while (cond) { __builtin_amdgcn_s_sleep(1); \
    if ((++_sp & 255u) == 0u) { if (xb_ld(&(bar)[XB_TMO])) break; if (_sp > XB_SPIN_CAP) { atomicAdd(&(bar)[XB_TMO], 1u); break; } } } } while (0)

struct XcdBarrier {
    unsigned* bar; unsigned x;
    volatile LAS unsigned* st;
};

__device__ __forceinline__ XcdBarrier xcd_barrier_post(unsigned* bar, volatile LAS unsigned* st) {
    XcdBarrier b; b.bar = bar; b.x = xb_xcc_id(); b.st = st;
    if (threadIdx.x == 0) (void)xb_add(&bar[XB_XCNT(b.x)], 1u);
    return b;
}
__device__ __forceinline__ void xcd_barrier_complete(unsigned* bar, unsigned x, unsigned& nloc, unsigned& nx) {
    const unsigned G = gridDim.x * gridDim.y * gridDim.z;
    unsigned sum, cnt, mine, sp = 0u;
    for (;;) {
        sum = 0u; cnt = 0u; mine = 0u;
#pragma unroll
        for (unsigned j = 0; j < 16; ++j) { const unsigned c = xb_ld(&bar[XB_XCNT(j)]); sum += c; cnt += (c > 0u) ? 1u : 0u; }
        mine = xb_ld(&bar[XB_XCNT(x)]);
        if (sum == G) break;
        __builtin_amdgcn_s_sleep(1);
        if ((++sp & 255u) == 0u) { if (xb_ld(&bar[XB_TMO])) break; if (sp > XB_SPIN_CAP) { atomicAdd(&bar[XB_TMO], 1u); break; } }
    }
    nloc = mine > 0u ? mine : 1u; nx = cnt > 0u ? cnt : 1u;
}

__device__ __forceinline__ void xcd_barrier(const XcdBarrier& b) {
    asm volatile("s_waitcnt vmcnt(0)" ::: "memory");
    __syncthreads();
    if (threadIdx.x == 0) {
        unsigned* bar = b.bar;
        __builtin_amdgcn_s_waitcnt(0);
        unsigned nloc = b.st[0], nx = b.st[1];
        if (nloc == 0u) { xcd_barrier_complete(bar, b.x, nloc, nx); b.st[0] = nloc; b.st[1] = nx; }
        const unsigned old = xb_add(&bar[XB_XSUB(b.x)], 1u);
        const unsigned gen = old / nloc;
        if (old + 1u == (gen + 1u) * nloc) {
            __builtin_amdgcn_fence(__ATOMIC_RELEASE, "agent");
            asm volatile("s_waitcnt vmcnt(0)" ::: "memory");
            const unsigned og = xb_add(&bar[XB_TOP], 1u);
            const unsigned tg = og / nx;
            if (og + 1u == (tg + 1u) * nx) xb_add(&bar[XB_TOPGEN], 1u);
            else XB_SPIN(xb_ld(&bar[XB_TOPGEN]) == tg, bar);
            __builtin_amdgcn_fence(__ATOMIC_ACQUIRE, "agent");
            xb_add(&bar[XB_XGEN(b.x)], 1u);
            asm volatile("s_waitcnt vmcnt(0)" ::: "memory");
        } else {
            XB_SPIN(xb_ld(&bar[XB_XGEN(b.x)]) == gen, bar);
            __builtin_amdgcn_fence(__ATOMIC_ACQUIRE, "agent");
            asm volatile("s_waitcnt vmcnt(0)" ::: "memory");
        }
    }
    __syncthreads();
}
namespace pg8 {
#define PG8_LAS __attribute__((address_space(3)))
typedef unsigned short bf16_t;
typedef short bf16x8 __attribute__((ext_vector_type(8)));
typedef float f32x4 __attribute__((ext_vector_type(4)));
typedef unsigned u32x4 __attribute__((ext_vector_type(4)));
constexpr int BM = 256, BK = 64, HALF = 128, HTB = HALF * BK * 2  , STAGE_BYTES = 8 * HTB, NXCD = 8, WGM = 8;

__host__ __device__ __forceinline__ int lds_byte(int r, int c) { const int st = (r >> 4) * 2 + (c >> 5), rr = r & 15, cc = c & 31, ob = rr * 64 + cc * 2; return st * 1024 + (ob ^ (((ob >> 9) & 1) << 5)); }
__host__ __device__ __forceinline__ void stage_rc(int b, int& R, int& C) { const int st = b / 1024, sb = b % 1024, swz = sb ^ (((sb >> 9) & 1) << 5); R = (st >> 1) * 16 + swz / 64; C = (st & 1) * 32 + (swz % 64) / 2; }
__host__ __device__ __forceinline__ int perm32(int rho) { const int n = rho >> 4, i = rho & 15; return 8 * (i >> 2) + 4 * n + (i & 3); }

struct Unit { int pm, pn; };
struct Gemm { const bf16_t* A; const bf16_t* Bt; int M, N, K, lda, ldb; };

struct StaticOrder {
    int nM, nN, nwg, G, c;
    __host__ __device__ void init(int M, int N, int G_, int c_) { nM = M / BM; nN = N / BM; nwg = nM * nN; G = G_; c = c_; }
    __host__ __device__ bool next(int i, Unit& u) const {
        const long L = (long)i * G + c; if (L >= nwg) return false;
        int wgid = (int)L; { const int q = nwg / NXCD, r = nwg % NXCD, xcd = wgid % NXCD, off = wgid / NXCD; wgid = (xcd < r ? xcd * (q + 1) : r * (q + 1) + (xcd - r) * q) + off; }
        const int nig = WGM * nN, gid = wgid / nig, fm = gid * WGM, gsz = (nM - fm) < WGM ? (nM - fm) : WGM;
        u.pm = fm + ((wgid % nig) % gsz); u.pn = (wgid % nig) / gsz; return true;
    }
    __device__ __forceinline__ void a_ready(const Unit&) const {}
    __device__ __forceinline__ void done(const Unit&) const {}
};

__device__ __forceinline__ unsigned cvt_pk_bf16(float lo, float hi) { unsigned r; asm volatile("v_cvt_pk_bf16_f32 %0, %1, %2" : "=v"(r) : "v"(lo), "v"(hi)); return r; }
template <class Epi, class Sched, bool ALIGN_EPI = false, bool SP2 = false>
__device__ __forceinline__ void gemm_phase(const int w0, PG8_LAS unsigned char* lds, const Gemm g, const Sched& S, const Epi& E) {
    const int tid = lt_tid(w0), wid = __builtin_amdgcn_readfirstlane(tid >> 6), lane = tid & 63, wr = wid >> 2, wc = wid & 3, fr = lane & 15, fq = lane >> 4;
    const int K = g.K, nt = K / BK;
    unsigned voffA[2], voffB[2];
#pragma unroll
    for (int i = 0; i < 2; ++i) { int R, C; stage_rc(tid * 16 + i * 8192, R, C); const int Rb = Epi::PERM ? ((R & ~31) + perm32(R & 31)) : R;
        voffA[i] = (unsigned)(R * g.lda + C) * 2u; voffB[i] = (unsigned)(Rb * g.ldb + C) * 2u; }
    const size_t kstep = (size_t)(BK * 2);
    const size_t hstepA = (size_t)HALF * g.lda * 2, hstepB = (size_t)HALF * g.ldb * 2;
    const size_t tstepA = 2 * hstepA, tstepB = 2 * hstepB;
    const unsigned ldsw = (unsigned)wid * 1024u;
    const int aoff = lds_byte(wr * 64 + fr, fq * 8), boff = lds_byte(wc * 32 + fr, fq * 8);
#define PG8_SA(b, h) (((b) * 2 + (h)) * HTB)
#define PG8_SB(b, h) ((4 + (b) * 2 + (h)) * HTB)
#define PG8_STAGE(bufoff, gbase, voff) do { _Pragma("unroll") for (int _i = 0; _i < 2; ++_i) \
        __builtin_amdgcn_global_load_lds((const unsigned*)((const char*)(gbase) + (voff)[_i]), (PG8_LAS unsigned*)(lds + (bufoff) + ldsw + _i * 8192), 16, 0, 0); } while (0)
#define PG8_LDA(dst, b, h) do { _Pragma("unroll") for (int m = 0; m < 4; ++m) _Pragma("unroll") for (int k = 0; k < 2; ++k) dst[m][k] = *(const PG8_LAS bf16x8*)(lds + PG8_SA(b, h) + aoff + m * 2048 + k * 1024); } while (0)
#define PG8_LDB(dst, b, h) do { _Pragma("unroll") for (int n = 0; n < 2; ++n) _Pragma("unroll") for (int k = 0; k < 2; ++k) dst[n][k] = *(const PG8_LAS bf16x8*)(lds + PG8_SB(b, h) + boff + n * 2048 + k * 1024); } while (0)
#define PG8_MMA(ai, bj, At, Bt) do { __builtin_amdgcn_s_setprio(1); _Pragma("unroll") for (int m = 0; m < 4; ++m) _Pragma("unroll") for (int n = 0; n < 2; ++n) _Pragma("unroll") for (int k = 0; k < 2; ++k) \
        acc[ai][bj][m][n] = __builtin_amdgcn_mfma_f32_16x16x32_bf16(Bt[n][k], At[m][k], acc[ai][bj][m][n], 0, 0, 0); __builtin_amdgcn_s_setprio(0); } while (0)
#define PG8_WAIT_V(n) asm volatile("s_waitcnt vmcnt(" #n ")" ::: "memory")
#define PG8_WAIT_L(n) asm volatile("s_waitcnt lgkmcnt(" #n ")" ::: "memory")
#define PG8_BAR __builtin_amdgcn_s_barrier()
#define PG8_SCHED __builtin_amdgcn_sched_barrier(0)
    Unit cur, nxt; int ui = 0;
    if (!S.next(0, cur)) return;
    f32x4 acc[2][2][4][2];
#pragma unroll
    for (int a = 0; a < 2; ++a)
#pragma unroll
        for (int b = 0; b < 2; ++b)
#pragma unroll
            for (int m = 0; m < 4; ++m)
#pragma unroll
                for (int n = 0; n < 2; ++n) acc[a][b][m][n] = (f32x4){0.f, 0.f, 0.f, 0.f};
    bf16x8 At[4][2], B0[2][2], B1[2][2];
    const char* cA = (const char*)g.A + (size_t)cur.pm * tstepA; const char* cB = (const char*)g.Bt + (size_t)cur.pn * tstepB;
    S.a_ready(cur);
    if constexpr (SP2) {
        PG8_STAGE(PG8_SB(0, 0), cB, voffB); PG8_STAGE(PG8_SB(0, 1), cB + hstepB, voffB); PG8_STAGE(PG8_SA(0, 0), cA, voffA); PG8_STAGE(PG8_SA(0, 1), cA + hstepA, voffA);
        if (wr == 1) PG8_BAR;
        PG8_WAIT_V(2); PG8_BAR;
        PG8_STAGE(PG8_SB(1, 0), cB + kstep, voffB); PG8_STAGE(PG8_SA(1, 0), cA + kstep, voffA); PG8_STAGE(PG8_SB(1, 1), cB + hstepB + kstep, voffB);
        PG8_WAIT_V(6); PG8_BAR;
    } else {
        PG8_STAGE(PG8_SB(0, 0), cB, voffB); PG8_STAGE(PG8_SA(0, 0), cA, voffA); PG8_STAGE(PG8_SB(0, 1), cB + hstepB, voffB); PG8_STAGE(PG8_SA(0, 1), cA + hstepA, voffA);
        if (wr == 1) PG8_BAR;
        PG8_WAIT_V(4); PG8_BAR;
        PG8_STAGE(PG8_SB(1, 0), cB + kstep, voffB); PG8_STAGE(PG8_SA(1, 0), cA + kstep, voffA); PG8_STAGE(PG8_SB(1, 1), cB + hstepB + kstep, voffB);
        PG8_WAIT_V(6); PG8_BAR;
    }
    for (;;) {
        const bool has_next = S.next(ui + 1, nxt);
        const char* nA = has_next ? (const char*)g.A + (size_t)nxt.pm * tstepA : cA; const char* nB = has_next ? (const char*)g.Bt + (size_t)nxt.pn * tstepB : cB;
        for (int t = 0; t < nt; t += 2) {
            const bool last = (t == nt - 2);
            const char* a1 = cA + (size_t)(t + 1) * kstep;
            const char* a2 = last ? nA : cA + (size_t)(t + 2) * kstep; const char* b2 = last ? nB : cB + (size_t)(t + 2) * kstep;
            const char* a3 = a2 + kstep; const char* b3 = b2 + kstep;
            if (last && has_next) S.a_ready(nxt);
            if constexpr (SP2) {
            PG8_LDB(B0, 0, 0); PG8_LDB(B1, 0, 1); PG8_SCHED; PG8_LDA(At, 0, 0); PG8_STAGE(PG8_SA(1, 1), a1 + hstepA, voffA);
            PG8_WAIT_V(8); PG8_WAIT_L(0); PG8_BAR; PG8_MMA(0, 0, At, B0); PG8_MMA(0, 1, At, B1); PG8_BAR; PG8_SCHED;
            PG8_LDA(At, 0, 1); PG8_STAGE(PG8_SB(0, 0), b2, voffB); PG8_STAGE(PG8_SB(0, 1), b2 + hstepB, voffB); PG8_STAGE(PG8_SA(0, 0), a2, voffA);
            PG8_WAIT_V(8); PG8_WAIT_L(0); PG8_BAR; PG8_MMA(1, 0, At, B0); PG8_MMA(1, 1, At, B1); PG8_BAR; PG8_SCHED;
            PG8_LDB(B0, 1, 0); PG8_LDB(B1, 1, 1); PG8_SCHED; PG8_LDA(At, 1, 0); PG8_STAGE(PG8_SA(0, 1), a2 + hstepA, voffA);
            PG8_WAIT_V(8); PG8_WAIT_L(0); PG8_BAR; PG8_MMA(0, 0, At, B0); PG8_MMA(0, 1, At, B1); PG8_BAR; PG8_SCHED;
            PG8_LDA(At, 1, 1); PG8_STAGE(PG8_SB(1, 0), b3, voffB); PG8_STAGE(PG8_SB(1, 1), b3 + hstepB, voffB); PG8_STAGE(PG8_SA(1, 0), a3, voffA);
            PG8_WAIT_V(8); PG8_WAIT_L(0); PG8_BAR; PG8_MMA(1, 0, At, B0); PG8_MMA(1, 1, At, B1); PG8_BAR; PG8_SCHED;
            } else {
            PG8_LDB(B0, 0, 0); PG8_SCHED; PG8_LDA(At, 0, 0); PG8_STAGE(PG8_SA(1, 1), a1 + hstepA, voffA);
            PG8_WAIT_L(8); PG8_BAR; PG8_WAIT_L(0); PG8_MMA(0, 0, At, B0); PG8_BAR; PG8_SCHED;
            PG8_LDB(B1, 0, 1); PG8_STAGE(PG8_SB(0, 0), b2, voffB);
            PG8_BAR; PG8_WAIT_L(0); PG8_MMA(0, 1, At, B1); PG8_BAR;
            PG8_LDA(At, 0, 1); PG8_STAGE(PG8_SA(0, 0), a2, voffA);
            PG8_BAR; PG8_WAIT_L(0); PG8_MMA(1, 0, At, B0); PG8_BAR; PG8_SCHED;
            PG8_STAGE(PG8_SB(0, 1), b2 + hstepB, voffB);
            PG8_WAIT_V(6); PG8_BAR; PG8_MMA(1, 1, At, B1); PG8_BAR;
            PG8_LDB(B0, 1, 0); PG8_SCHED; PG8_LDA(At, 1, 0); PG8_STAGE(PG8_SA(0, 1), a2 + hstepA, voffA);
            PG8_WAIT_L(8); PG8_BAR; PG8_WAIT_L(0); PG8_MMA(0, 0, At, B0); PG8_BAR; PG8_SCHED;
            PG8_LDB(B1, 1, 1); PG8_STAGE(PG8_SB(1, 0), b3, voffB);
            PG8_BAR; PG8_WAIT_L(0); PG8_MMA(0, 1, At, B1); PG8_BAR;
            PG8_LDA(At, 1, 1); PG8_STAGE(PG8_SA(1, 0), a3, voffA);
            PG8_BAR; PG8_WAIT_L(0); PG8_MMA(1, 0, At, B0); PG8_BAR; PG8_SCHED;
            PG8_STAGE(PG8_SB(1, 1), b3 + hstepB, voffB);
            PG8_WAIT_V(6); PG8_BAR; PG8_MMA(1, 1, At, B1); PG8_BAR;
            }
        }
        if constexpr (ALIGN_EPI) { if (wr == 0) PG8_BAR; }
        if constexpr (!Epi::AFTER_DRAIN) { E(acc, cur, wr, wc, fr, fq); S.done(cur); }
        if (!has_next) break;
#pragma unroll
        for (int a = 0; a < 2; ++a)
#pragma unroll
            for (int b = 0; b < 2; ++b)
#pragma unroll
                for (int m = 0; m < 4; ++m)
#pragma unroll
                    for (int n = 0; n < 2; ++n) acc[a][b][m][n] = (f32x4){0.f, 0.f, 0.f, 0.f};
        cur = nxt; cA = nA; cB = nB; ++ui;
        if constexpr (ALIGN_EPI) { if (wr == 1) PG8_BAR; }
    }
    PG8_WAIT_V(0);
    if constexpr (!ALIGN_EPI) { if (wr == 0) PG8_BAR; }
    PG8_BAR;
    if constexpr (Epi::AFTER_DRAIN) { E.fused(acc, cur, wr, wc, fr, fq, lds, wid, lane); S.done(cur); }
#undef PG8_SA
#undef PG8_SB
#undef PG8_STAGE
#undef PG8_LDA
#undef PG8_LDB
#undef PG8_MMA
#undef PG8_WAIT_V
#undef PG8_WAIT_L
#undef PG8_BAR
#undef PG8_SCHED
}
}
constexpr int NWAVES = 8;
constexpr int SEQ = 8192, BATCH = 2, M = BATCH * SEQ, D = 1024, DFF = 2816, NZ = 6912  , DIN_SRC = 6864;
constexpr float EPSN = 1e-6f;
constexpr float LOG2E = 1.4426950408889634f;
constexpr int ZC_CQ = 0, ZC_CKV = 256, ZC_KROPE = 384, ZC_GA = 416, ZC_XW = 432, ZC_GQ = 512, ZC_GK = 768, ZC_GV = 1024, ZC_GG = 1536,
              ZC_RR = 2048, ZC_RK = 2560, ZC_RV = 3072, ZC_XA = 3584, ZC_XG = 3648, ZC_GATE = 3840;
constexpr size_t MiB = 1u << 20;
constexpr size_t WS_CTL = 0, CTL_ZERO_BYTES = 1 * MiB;
constexpr size_t WS_CS = 1 * MiB;
constexpr size_t WS_RS = 3 * MiB;
constexpr size_t WS_MEMN = 4 * MiB;
constexpr size_t WS_MEMKV = 5 * MiB;
constexpr size_t WS_GDEC = 7 * MiB;
constexpr size_t WS_W = 8 * MiB;
constexpr size_t WS_XN = 70 * MiB;
constexpr size_t WS_Y = 102 * MiB;
constexpr size_t WS_ZH = 166 * MiB;
constexpr size_t WS_Q = 382 * MiB;
constexpr size_t WS_K = 406 * MiB;
constexpr size_t WS_V = 430 * MiB;
constexpr size_t WS_OABC = 446 * MiB;
constexpr size_t WS_GU = 494 * MiB;
constexpr size_t WS_GS = 526 * MiB;
constexpr size_t WS_RA = 542 * MiB;
constexpr size_t WS_RQ = 558 * MiB;
constexpr size_t WS_RSC = 574 * MiB;
constexpr size_t WS_E1 = 590 * MiB;
constexpr size_t WS_E2 = 606 * MiB;
constexpr size_t WS_END = 622 * MiB;
constexpr size_t W_FFN_IN0 = 0, W_FFN_IN1 = 5767168, W_FFN_OUT0 = 11534336, W_FFN_OUT1 = 14417920, W_IN = 17301504, W_UQ = 24379392, W_UKV = 24576000,
                 W_BR = 24707072, W_OUT = 26279936, W_MQ = 27328512, W_MKV = 28377088, W_MO = 30474240, W_TOTAL = 31522816;
constexpr int CW_TMO = 0, CW_CODE = 1, CW_BAR = 4096;
constexpr int RING_OFF = 0;
constexpr int LDS_BYTES = 155648;
constexpr int MISC_OFF = 150 * 1024;

typedef short s16x4 __attribute__((ext_vector_type(4)));
typedef float f32x16 __attribute__((ext_vector_type(16)));
typedef float f32x2 __attribute__((ext_vector_type(2)));
typedef unsigned u32x2 __attribute__((ext_vector_type(2)));
typedef unsigned u32x4 __attribute__((ext_vector_type(4)));
typedef short v4i16_t __attribute__((ext_vector_type(4)));

__device__ __forceinline__ float bf2f(unsigned short b) { return __builtin_bit_cast(float, (unsigned)b << 16); }
__device__ __forceinline__ float bflo(unsigned w) { return __builtin_bit_cast(float, w << 16); }
__device__ __forceinline__ float bfhi(unsigned w) { return __builtin_bit_cast(float, w & 0xffff0000u); }
__device__ __forceinline__ float fast_exp2(float x) { return __builtin_amdgcn_exp2f(x); }
__device__ __forceinline__ float fast_rcp(float x) { return __builtin_amdgcn_rcpf(x); }
__device__ __forceinline__ float sigmoid_f(float x) { return fast_rcp(1.f + fast_exp2(-x * LOG2E)); }
__device__ __forceinline__ float silu_f(float x) { return x * sigmoid_f(x); }
__device__ __forceinline__ float softplus_nabs(float x) { return 0.6931471805599453f * __builtin_amdgcn_logf(1.f + fast_exp2(-fabsf(x) * LOG2E)); }
template <int K> __device__ __forceinline__ float swz_xor(float v) { static_assert(K == 1 || K == 2 || K == 4 || K == 8 || K == 16, "swizzle xor inside 32 lanes"); return __builtin_bit_cast(float, __builtin_amdgcn_ds_swizzle(__builtin_bit_cast(int, v), (K << 10) | 0x1f)); }
__device__ __forceinline__ float xor32_val(float v) { const unsigned x = __float_as_uint(v); auto rr = __builtin_amdgcn_permlane32_swap(x, x, false, false); return __uint_as_float(rr[0] ^ rr[1] ^ x); }
__device__ __forceinline__ float add_x16_x32(float s) { s += swz_xor<16>(s); s += xor32_val(s); return s; }
__device__ __forceinline__ float shfl_up_l(float v, int lane, int off) { const int src = lane >= off ? lane - off : lane; return __builtin_bit_cast(float, __builtin_amdgcn_ds_bpermute(src << 2, __builtin_bit_cast(int, v))); }
__device__ __forceinline__ float wave_sum(float v) { v += swz_xor<1>(v); v += swz_xor<2>(v); v += swz_xor<4>(v); v += swz_xor<8>(v); v += swz_xor<16>(v); v += xor32_val(v); return v; }
template <bool KS> __device__ __forceinline__ bf16x8 ldfrag(const LAS unsigned char* base, int pitch, int row0, int k0, int lane) {
    if constexpr (!KS) {
        return *(const LAS bf16x8*)(base + (row0 + (lane & 15)) * pitch + (k0 + 8 * (lane >> 4)) * 2);
    } else {
        const int g = lane >> 4, q = (lane & 15) >> 2, p = lane & 3;
        const LAS unsigned char* a = base + (k0 + 8 * g + q) * pitch + (row0 + 4 * p) * 2;
        const v4i16_t lo = __builtin_amdgcn_ds_read_tr16_b64_v4i16((LAS v4i16_t*)a);
        const v4i16_t hi = __builtin_amdgcn_ds_read_tr16_b64_v4i16((LAS v4i16_t*)(a + 4 * pitch));
        return (bf16x8){lo[0], lo[1], lo[2], lo[3], hi[0], hi[1], hi[2], hi[3]};
    }
}
template <bool MKS, bool NKS, int K> __device__ __forceinline__ void mm16(f32x4& acc, const LAS unsigned char* Mb, int mp, int mrow0, const LAS unsigned char* Nb, int np, int nrow0, int lane) {
#pragma unroll
    for (int k0 = 0; k0 < K; k0 += 32) acc = __builtin_amdgcn_mfma_f32_16x16x32_bf16(ldfrag<NKS>(Nb, np, nrow0, k0, lane), ldfrag<MKS>(Mb, mp, mrow0, k0, lane), acc, 0, 0, 0);
}
__device__ __forceinline__ bf16x8 gfrag(const bf16* base, int pitch_el, int row0, int k0, int lane) {
    return *(const bf16x8*)(base + (size_t)(row0 + (lane & 15)) * pitch_el + k0 + 8 * (lane >> 4));
}
__device__ __forceinline__ u32x2 pack4(f32x4 v) { u32x2 r; r.x = pk2(v[0], v[1]); r.y = pk2(v[2], v[3]); return r; }
__device__ __forceinline__ f32x4 unpack4(u32x2 w) { return (f32x4){bflo(w.x), bfhi(w.x), bflo(w.y), bfhi(w.y)}; }
#define WG_SYNC() __syncthreads()
typedef f32x4 AccT[2][2][4][2];
#define EPI_LAUNDER unsigned char* ws = wsb; asm volatile("" : "+s"(ws), "+s"(wr), "+s"(wc)); asm volatile("" : "+v"(fr), "+v"(fq));
using pg8::Unit;
#define EPI_ROWS_BEGIN _Pragma("unroll") for (int ai = 0; ai < 2; ++ai) _Pragma("unroll") for (int m = 0; m < 4; ++m) { const int row = u.pm * 256 + ai * 128 + wr * 64 + m * 16 + fr;
#define EPI_ROWS_END }
__device__ __forceinline__ u32x4 pack8(f32x4 a, f32x4 b) { u32x4 w; w.x = pg8::cvt_pk_bf16(a[0], a[1]); w.y = pg8::cvt_pk_bf16(a[2], a[3]); w.z = pg8::cvt_pk_bf16(b[0], b[1]); w.w = pg8::cvt_pk_bf16(b[2], b[3]); return w; }

struct EpiSwiglu {
    static constexpr bool PERM = true, AFTER_DRAIN = false;
    unsigned char* wsb;
    __device__ __forceinline__ void operator()(const AccT& acc, const Unit& u, int wr, int wc, int fr, int fq) const {
        EPI_LAUNDER
        bf16* H = (bf16*)(ws + WS_ZH); const int col = u.pn * 128 + wc * 32 + 8 * fq;
        EPI_ROWS_BEGIN
            f32x4 o[2];
#pragma unroll
            for (int n = 0; n < 2; ++n)
#pragma unroll
                for (int j = 0; j < 4; ++j) { const float g = acc[ai][0][m][n][j]; o[n][j] = silu_f(g) * acc[ai][1][m][n][j]; }
            *(u32x4*)(H + (size_t)row * DFF + col) = pack8(o[0], o[1]);
        EPI_ROWS_END
    }
};
struct EpiF32 {
    static constexpr bool PERM = false, AFTER_DRAIN = false;
    unsigned char* wsb;
    __device__ __forceinline__ void operator()(const AccT& acc, const Unit& u, int wr, int wc, int fr, int fq) const {
        EPI_LAUNDER
        float* Y = (float*)(ws + WS_Y); constexpr int ldc = D;
        EPI_ROWS_BEGIN
#pragma unroll
            for (int bj = 0; bj < 2; ++bj)
#pragma unroll
                for (int n = 0; n < 2; ++n) *(f32x4*)(Y + (size_t)row * ldc + u.pn * 256 + bj * 128 + wc * 32 + 16 * n + 4 * fq) = acc[ai][bj][m][n];
        EPI_ROWS_END
    }
};
template <int WHICH  > struct EpiBf16S {
    static constexpr bool PERM = true, AFTER_DRAIN = false;
    unsigned char* wsb;
    __device__ __forceinline__ void operator()(const AccT& acc, const Unit& u, int wr, int wc, int fr, int fq) const {
        EPI_LAUNDER
        bf16* O = (bf16*)(ws + (WHICH == 0 ? WS_MEMKV : WS_Q)); constexpr int ldc = WHICH == 0 ? 2 * D : D; const float scale = WHICH == 0 ? 1.f : 0.0625f * LOG2E;
        EPI_ROWS_BEGIN
#pragma unroll
            for (int bj = 0; bj < 2; ++bj)
                *(u32x4*)(O + (size_t)row * ldc + u.pn * 256 + bj * 128 + wc * 32 + 8 * fq) = pack8(acc[ai][bj][m][0] * scale, acc[ai][bj][m][1] * scale);
        EPI_ROWS_END
    }
};
struct EpiZ {
    static constexpr bool PERM = true, AFTER_DRAIN = false;
    unsigned char* wsb;
    __device__ __forceinline__ void operator()(const AccT& acc, const Unit& u, int wr, int wc, int fr, int fq) const {
        EPI_LAUNDER
        bf16* Z = (bf16*)(ws + WS_ZH); float* RS = (float*)(ws + WS_RS);
        EPI_ROWS_BEGIN
#pragma unroll
            for (int bj = 0; bj < 2; ++bj)
                *(u32x4*)(Z + (size_t)row * NZ + u.pn * 256 + bj * 128 + wc * 32 + 8 * fq) = pack8(acc[ai][bj][m][0], acc[ai][bj][m][1]);
            if (u.pn < 2) {
                float s = 0.f;
#pragma unroll
                for (int bj = 0; bj < 2; ++bj) if (u.pn == 0 || bj == 0)
#pragma unroll
                    for (int n = 0; n < 2; ++n) { const f32x4 v = acc[ai][bj][m][n]; s += (v[0] * v[0] + v[1] * v[1]) + (v[2] * v[2] + v[3] * v[3]); }
                s = add_x16_x32(s);
                if (fq == 0) RS[(size_t)row * 8 + u.pn * 4 + wc] = s;
            }
        EPI_ROWS_END
    }
};
struct EpiQ {
    static constexpr bool PERM = true, AFTER_DRAIN = false;
    unsigned char* wsb;
    __device__ __forceinline__ void operator()(const AccT& acc, const Unit& u, int wr, int wc, int fr, int fq) const {
        EPI_LAUNDER
        bf16* Q = (bf16*)(ws + WS_Q); const float* RS = (const float*)(ws + WS_RS);
        const float C2Q = 0.10206207261596577f * LOG2E;
        EPI_ROWS_BEGIN
            const f32x4 p = *(const f32x4*)(RS + (size_t)row * 8);
            const float sc = rsqrtf(((p[0] + p[1]) + (p[2] + p[3])) * (1.f / 256.f) + EPSN) * C2Q;
#pragma unroll
            for (int bj = 0; bj < 2; ++bj)
                *(u32x4*)(Q + (size_t)row * 768 + u.pn * 256 + bj * 128 + wc * 32 + 8 * fq) = pack8(acc[ai][bj][m][0] * sc, acc[ai][bj][m][1] * sc);
        EPI_ROWS_END
    }
};
struct EpiKV {
    static constexpr bool PERM = true, AFTER_DRAIN = false;
    unsigned char* wsb;
    __device__ __forceinline__ void operator()(const AccT& acc, const Unit& u, int wr, int wc, int fr, int fq) const {
        EPI_LAUNDER
        bf16* K = (bf16*)(ws + WS_K); bf16* V = (bf16*)(ws + WS_V); const float* RS = (const float*)(ws + WS_RS);
        EPI_ROWS_BEGIN
            const f32x4 p = *(const f32x4*)(RS + (size_t)row * 8 + 4);
            const float sc = rsqrtf(((p[0] + p[1]) + (p[2] + p[3])) * (1.f / 128.f) + EPSN);
#pragma unroll
            for (int bj = 0; bj < 2; ++bj) {
                const int head = u.pn * 2 + bj;
                const u32x4 w = pack8(acc[ai][bj][m][0] * sc, acc[ai][bj][m][1] * sc);
                if (wc < 2) *(u32x4*)(K + (size_t)row * 768 + head * 96 + wc * 32 + 8 * fq) = w;
                else *(u32x4*)(V + (size_t)row * 512 + head * 64 + (wc - 2) * 32 + 8 * fq) = w;
            }
        EPI_ROWS_END
    }
};
template <int MODE> struct EpiBranch {
    static constexpr bool PERM = true, AFTER_DRAIN = false;
    unsigned char* wsb;
    __device__ __forceinline__ void operator()(const AccT& acc, const Unit& u, int wr, int wc, int fr, int fq) const {
        EPI_LAUNDER
        const bf16* Z = (const bf16*)(ws + WS_ZH); float* Y = (float*)(ws + WS_Y); bf16* MG = (bf16*)(ws + WS_XN); constexpr int bi = MODE;
        EPI_ROWS_BEGIN
#pragma unroll
            for (int bj = 0; bj < 2; ++bj) {
                const int col = u.pn * 256 + bj * 128 + wc * 32 + 8 * fq;
                const u32x4 gw = *(const u32x4*)(Z + (size_t)row * NZ + ZC_GATE + bi * 1024 + col);
                f32x4 v0, v1;
                v0[0] = acc[ai][bj][m][0][0] * sigmoid_f(bflo(gw.x)); v0[1] = acc[ai][bj][m][0][1] * sigmoid_f(bfhi(gw.x));
                v0[2] = acc[ai][bj][m][0][2] * sigmoid_f(bflo(gw.y)); v0[3] = acc[ai][bj][m][0][3] * sigmoid_f(bfhi(gw.y));
                v1[0] = acc[ai][bj][m][1][0] * sigmoid_f(bflo(gw.z)); v1[1] = acc[ai][bj][m][1][1] * sigmoid_f(bfhi(gw.z));
                v1[2] = acc[ai][bj][m][1][2] * sigmoid_f(bflo(gw.w)); v1[3] = acc[ai][bj][m][1][3] * sigmoid_f(bfhi(gw.w));
                float* yp = Y + (size_t)row * D + col;
                if (MODE > 0) { v0 += *(const f32x4*)(yp); v1 += *(const f32x4*)(yp + 4); }
                if (MODE < 2) { *(f32x4*)(yp) = v0; *(f32x4*)(yp + 4) = v1; }
                else *(u32x4*)(MG + (size_t)row * D + col) = pack8(v0, v1);
            }
        EPI_ROWS_END
    }
};
namespace att {
__device__ __forceinline__ int crow(int r, int hi) { return (r & 3) + 8 * (r >> 2) + 4 * hi; }
__device__ __forceinline__ float pl32_max(float m) { auto rr = __builtin_amdgcn_permlane32_swap(__float_as_uint(m), __float_as_uint(m), false, false); return fmaxf(__uint_as_float(rr[0]), __uint_as_float(rr[1])); }
__device__ __forceinline__ float pl32_sum(float m) { auto rr = __builtin_amdgcn_permlane32_swap(__float_as_uint(m), __float_as_uint(m), false, false); return __uint_as_float(rr[0]) + __uint_as_float(rr[1]); }

template <int DK, int DV> struct Lay {
    static constexpr int KSLOT = DK * 128, VSLOT = DV * 128, K_OFF = 0, V_OFF = 2 * KSLOT, WS_OFF = V_OFF + 2 * VSLOT, BYTES = WS_OFF + 8 * 512;
    static_assert(8 * 32 * DV * 2 <= 2 * KSLOT + 2 * VSLOT, "O staging must fit in the K and V slots");
};
template <int DK, int DV, bool CAUSAL, bool ROPEQ>
__device__ __forceinline__ void attn_unit(const int w0, const float* CSq  , const bf16* Qp, int qpitch, const bf16* Kp, int kpitch, const bf16* Vp, int vpitch, bf16* Op, int opitch, int q0, int NT, LAS unsigned char* shm) {
    typedef Lay<DK, DV> L;
    constexpr int NKCH = DK / 8, NVBL = (DV / 32) * 4, ND = DK / 16, NO = DV / 32;
    const int tid = lt_tid(w0), lane = tid & 63, r32 = lane & 31, hi = lane >> 5;
    const int wid = __builtin_amdgcn_readfirstlane(tid >> 6);
    LAS float* wsf = (LAS float*)(shm + L::WS_OFF) + wid * 128;
#define ATT_ISSUE(t_, slot_) do { _Pragma("unroll") for (int i0 = 0; i0 < NKCH + NVBL; i0 += 8) { const int i = i0 + wid; \
        if (i < NKCH) { const bf16* src = Kp + (size_t)(64 * (t_) + lane) * kpitch + i * 8; \
            __builtin_amdgcn_global_load_lds((const unsigned*)src, (LAS unsigned*)(shm + L::K_OFF + (slot_) * L::KSLOT + i * 1024), 16, 0, 0); } \
        else if (i < NKCH + NVBL) { const int blk = i - NKCH, dh = blk >> 2, kg = blk & 3; \
            const bf16* src = Vp + (size_t)(64 * (t_) + 16 * kg + (lane >> 2)) * vpitch + dh * 32 + (lane & 3) * 8; \
            __builtin_amdgcn_global_load_lds((const unsigned*)src, (LAS unsigned*)(shm + L::V_OFF + (slot_) * L::VSLOT + blk * 1024), 16, 0, 0); } } } while (0)
    ATT_ISSUE(0, 0);
    bf16x8 qr[ND];
#pragma unroll
    for (int d0 = 0; d0 < ND; ++d0) qr[d0] = *(const bf16x8*)(Qp + (size_t)(wid * 32 + r32) * qpitch + d0 * 16 + hi * 8);
    if constexpr (ROPEQ) {
        const float* cs = CSq + (size_t)(wid * 32 + r32) * 32 + 16 * hi;
        const f32x4 c0 = *(const f32x4*)cs, c1 = *(const f32x4*)(cs + 4), c2 = *(const f32x4*)(cs + 8), c3 = *(const f32x4*)(cs + 12);
        const float cosv[8] = {c0[0], c0[2], c1[0], c1[2], c2[0], c2[2], c3[0], c3[2]}, sinv[8] = {c0[1], c0[3], c1[1], c1[3], c2[1], c2[3], c3[1], c3[3]};
        const u32x4 w1 = __builtin_bit_cast(u32x4, qr[ND - 2]), w2 = __builtin_bit_cast(u32x4, qr[ND - 1]); u32x4 o1, o2;
#pragma unroll
        for (int j = 0; j < 4; ++j) { const float a0 = bflo(w1[j]), a1 = bfhi(w1[j]), b0 = bflo(w2[j]), b1 = bfhi(w2[j]);
            o1[j] = pk2(a0 * cosv[2 * j] - b0 * sinv[2 * j], a1 * cosv[2 * j + 1] - b1 * sinv[2 * j + 1]);
            o2[j] = pk2(a0 * sinv[2 * j] + b0 * cosv[2 * j], a1 * sinv[2 * j + 1] + b1 * cosv[2 * j + 1]); }
        qr[ND - 2] = __builtin_bit_cast(bf16x8, o1); qr[ND - 1] = __builtin_bit_cast(bf16x8, o2);
    }
    f32x16 o[NO];
#pragma unroll
    for (int i = 0; i < NO; ++i) o[i] = f32x16{};
    float mrow = -1e30f, lsum = 0.f;
    const int qme = q0 + wid * 32 + r32, qmin_w = q0 + wid * 32, qmax_w = qmin_w + 31;
    asm volatile("s_waitcnt vmcnt(0)" ::: "memory");
    __syncthreads();
    for (int t = 0; t < NT; ++t) {
        const int slot = t & 1;
        if (t + 1 < NT) ATT_ISSUE(t + 1, slot ^ 1);
        const bool active = !CAUSAL || (64 * t <= qmax_w);
        if (active) {
            const LAS unsigned char* kb = shm + L::K_OFF + slot * L::KSLOT + hi * 1024 + r32 * 16;
            f32x16 p0 = f32x16{}, p1 = f32x16{};
#pragma unroll
            for (int d0 = 0; d0 < ND; ++d0) {
                const bf16x8 b0 = *(const LAS bf16x8*)(kb + d0 * 2048), b1 = *(const LAS bf16x8*)(kb + d0 * 2048 + 512);
                p0 = __builtin_amdgcn_mfma_f32_32x32x16_bf16(b0, qr[d0], p0, 0, 0, 0);
                p1 = __builtin_amdgcn_mfma_f32_32x32x16_bf16(b1, qr[d0], p1, 0, 0, 0);
            }
            if (CAUSAL && (64 * t + 63 > qmin_w)) {
#pragma unroll
                for (int r = 0; r < 16; ++r) { const int kv = 64 * t + crow(r, hi); if (kv > qme) p0[r] = -INFINITY; if (kv + 32 > qme) p1[r] = -INFINITY; }
            }
            float rm = fmaxf(p0[0], p1[0]);
#pragma unroll
            for (int r = 1; r < 16; ++r) rm = fmaxf(rm, fmaxf(p0[r], p1[r]));
            rm = pl32_max(rm);
            const float mnew = fmaxf(mrow, rm), f = fast_exp2(mrow - mnew);
            mrow = mnew;
            float ls = 0.f;
#pragma unroll
            for (int r = 0; r < 16; ++r) { p0[r] = fast_exp2(p0[r] - mnew); p1[r] = fast_exp2(p1[r] - mnew); ls += p0[r] + p1[r]; }
            lsum = lsum * f + ls;
            if (hi == 0) wsf[r32] = f;
            asm volatile("s_waitcnt lgkmcnt(0)" ::: "memory");
#pragma unroll
            for (int g = 0; g < 4; ++g) { const f32x4 fv = *(const LAS f32x4*)(wsf + 8 * g + 4 * hi);
#pragma unroll
                for (int i = 0; i < NO; ++i) { o[i][4 * g + 0] *= fv[0]; o[i][4 * g + 1] *= fv[1]; o[i][4 * g + 2] *= fv[2]; o[i][4 * g + 3] *= fv[3]; } }
            u32x4 pw[4];
#pragma unroll
            for (int j = 0; j < 4; ++j) { pw[0][j] = pk2(p0[2 * j], p0[2 * j + 1]); pw[1][j] = pk2(p0[8 + 2 * j], p0[8 + 2 * j + 1]); pw[2][j] = pk2(p1[2 * j], p1[2 * j + 1]); pw[3][j] = pk2(p1[8 + 2 * j], p1[8 + 2 * j + 1]); }
            const LAS unsigned char* vb = shm + L::V_OFF + slot * L::VSLOT + ((lane >> 4) & 1) * 32 + (lane & 3) * 8 + (4 * hi + ((lane & 15) >> 2)) * 64;
#pragma unroll
            for (int d0 = 0; d0 < NO; ++d0)
#pragma unroll
                for (int ks = 0; ks < 4; ++ks) {
                    const v4i16_t lo = __builtin_amdgcn_ds_read_tr16_b64_v4i16((LAS v4i16_t*)(vb + d0 * 4096 + ks * 1024));
                    const v4i16_t hv = __builtin_amdgcn_ds_read_tr16_b64_v4i16((LAS v4i16_t*)(vb + d0 * 4096 + ks * 1024 + 512));
                    const bf16x8 vf = (bf16x8){lo[0], lo[1], lo[2], lo[3], hv[0], hv[1], hv[2], hv[3]};
                    o[d0] = __builtin_amdgcn_mfma_f32_32x32x16_bf16(__builtin_bit_cast(bf16x8, pw[ks]), vf, o[d0], 0, 0, 0);
                }
        }
        asm volatile("s_waitcnt vmcnt(0) lgkmcnt(0)" ::: "memory");
        __syncthreads();
    }
    lsum = pl32_sum(lsum);
    if (hi == 0) wsf[64 + r32] = lsum;
    asm volatile("s_waitcnt lgkmcnt(0)" ::: "memory");
    LAS bf16* stg = (LAS bf16*)(shm + L::K_OFF) + wid * 32 * DV;
#pragma unroll
    for (int r = 0; r < 16; ++r) { const int orow = crow(r, hi); const float il = fast_rcp(wsf[64 + orow]);
#pragma unroll
        for (int d0 = 0; d0 < NO; ++d0) stg[orow * DV + d0 * 32 + r32] = (bf16)f2bf(o[d0][r] * il); }
    asm volatile("s_waitcnt lgkmcnt(0)" ::: "memory");
    constexpr int CPR = DV / 8;
#pragma unroll
    for (int i = 0; i < (32 * CPR) / 64; ++i) { const int idx = i * 64 + lane, row = idx / CPR, ch = idx % CPR;
        const u32x4 v = *(const LAS u32x4*)(stg + row * DV + ch * 8);
        *(u32x4*)(Op + (size_t)(wid * 32 + row) * opitch + ch * 8) = v; }
    asm volatile("s_waitcnt lgkmcnt(0)" ::: "memory");
    __syncthreads();
}
#undef ATT_ISSUE
}
namespace gla {
constexpr int P72 = 144, P136 = 272;
constexpr int L_G = 0;
constexpr int L_WA = 16640;
constexpr int L_A = 20992;
constexpr int L_B = 30208;
constexpr int L_SM = 39424;
constexpr int L_V = 48640;
constexpr int L_ST = 66048;
constexpr int L_PART = 83456;
struct Ptrs { const bf16* Z; const float* w_alpha; const float* b_alpha; const float* gnorm; float* GU; bf16* GS; float* GDEC; bf16* OABC; };

__device__ __forceinline__ void logdecay_cumsum(const Ptrs& P, LAS unsigned char* lds, int row0, int h, int tid, int lane, int wid) {
    LAS float* G = (LAS float*)(lds + L_G); LAS float* WA = (LAS float*)(lds + L_WA);
    for (int i = tid; i < 16 * 64 + 64; i += 512) WA[i] = (i < 1024) ? P.w_alpha[(i >> 6) * 256 + h * 64 + (i & 63)] : P.b_alpha[h * 64 + (i - 1024)];
    const int t = tid >> 3, d0 = (tid & 7) * 8;
    const u32x4 a0 = *(const u32x4*)(P.Z + (size_t)(row0 + t) * NZ + ZC_GA), a1 = *(const u32x4*)(P.Z + (size_t)(row0 + t) * NZ + ZC_GA + 8);
    const float av[16] = {bflo(a0.x), bfhi(a0.x), bflo(a0.y), bfhi(a0.y), bflo(a0.z), bfhi(a0.z), bflo(a0.w), bfhi(a0.w), bflo(a1.x), bfhi(a1.x), bflo(a1.y), bfhi(a1.y), bflo(a1.z), bfhi(a1.z), bflo(a1.w), bfhi(a1.w)};
    WG_SYNC();
#pragma unroll
    for (int j = 0; j < 8; ++j) { const int d = d0 + j; float x = WA[1024 + d];
#pragma unroll
        for (int k = 0; k < 16; ++k) x += av[k] * WA[k * 64 + d];
        const float ls = fminf(x, 0.f) - softplus_nabs(x);
        G[t * 65 + d] = ls * (1.f / 16.f); }
    WG_SYNC();
#pragma unroll
    for (int j = 0; j < 8; ++j) { const int d = wid * 8 + j; float v = G[lane * 65 + d];
#pragma unroll
        for (int off = 1; off < 64; off <<= 1) { const float n = shfl_up_l(v, lane, off); if (lane >= off) v += n; }
        G[lane * 65 + d] = v; }
    WG_SYNC();
}
__device__ __forceinline__ void gl1_unit(const int w0, const Ptrs& P, LAS unsigned char* lds, int unit) {
    const int tid = lt_tid(w0), lane = tid & 63, wid = __builtin_amdgcn_readfirstlane(tid >> 6);
    const int h = unit & 3, bc = unit >> 2, row0 = (bc >> 7) * SEQ + (bc & 127) * 64;
    logdecay_cumsum(P, lds, row0, h, tid, lane, wid);
    const LAS float* G = (const LAS float*)(lds + L_G);
    { const int t = tid >> 3, d0 = (tid & 7) * 8;
      const u32x4 kw = *(const u32x4*)(P.Z + (size_t)(row0 + t) * NZ + ZC_GK + h * 64 + d0);
      const float kv[8] = {bflo(kw.x), bfhi(kw.x), bflo(kw.y), bfhi(kw.y), bflo(kw.z), bfhi(kw.z), bflo(kw.w), bfhi(kw.w)};
      float o[8];
#pragma unroll
      for (int j = 0; j < 8; ++j) o[j] = kv[j] * __expf(G[63 * 65 + d0 + j] - G[t * 65 + d0 + j]);
      u32x4 w; w.x = pk2(o[0], o[1]); w.y = pk2(o[2], o[3]); w.z = pk2(o[4], o[5]); w.w = pk2(o[6], o[7]);
      *(LAS u32x4*)(lds + L_A + t * P72 + d0 * 2) = w;
      const int v0 = (tid & 7) * 16;
      const bf16* vp = P.Z + (size_t)(row0 + t) * NZ + ZC_GV + h * 128 + v0;
      *(LAS u32x4*)(lds + L_V + t * P136 + v0 * 2) = *(const u32x4*)vp; *(LAS u32x4*)(lds + L_V + t * P136 + v0 * 2 + 16) = *(const u32x4*)(vp + 8); }
    if (tid < 64) P.GDEC[(size_t)unit * 64 + tid] = __expf(G[63 * 65 + tid]);
    WG_SYNC();
    const int mb = wid & 3;
#pragma unroll
    for (int i = 0; i < 4; ++i) { const int nb = 4 * (wid >> 2) + i; f32x4 acc = {0.f, 0.f, 0.f, 0.f};
        mm16<true, true, 64>(acc, lds + L_A, P72, 16 * mb, lds + L_V, P136, 16 * nb, lane);
        *(f32x4*)(P.GU + ((size_t)unit * 64 + 16 * mb + (lane & 15)) * 128 + 16 * nb + 4 * (lane >> 4)) = acc; }
    WG_SYNC();
}
__device__ __forceinline__ void gl2_item(const int w0, const Ptrs& P, int item) {
    const int tid = lt_tid(w0), chain = item >> 2, b = chain >> 2, h = chain & 3, d = (item & 3) * 16 + (tid >> 5), v0 = (tid & 31) * 4;
    f32x4 s = {0.f, 0.f, 0.f, 0.f};
#pragma unroll 8
    for (int c = 0; c < 128; ++c) { const size_t unit = (size_t)(b * 128 + c) * 4 + h;
        *(u32x2*)(P.GS + (unit * 64 + d) * 128 + v0) = pack4(s);
        const f32x4 uu = *(const f32x4*)(P.GU + (unit * 64 + d) * 128 + v0); const float dec = P.GDEC[unit * 64 + d];
        s = s * dec + uu; }
}
__device__ __forceinline__ void gl3_unit(const int w0, const Ptrs& P, LAS unsigned char* lds, int unit) {
    const int tid = lt_tid(w0), lane = tid & 63, wid = __builtin_amdgcn_readfirstlane(tid >> 6);
    const int h = unit & 3, bc = unit >> 2, row0 = (bc >> 7) * SEQ + (bc & 127) * 64;
    logdecay_cumsum(P, lds, row0, h, tid, lane, wid);
    const LAS float* G = (const LAS float*)(lds + L_G);
    { const int t = tid >> 3, d0 = (tid & 7) * 8;
      const u32x4 qw = *(const u32x4*)(P.Z + (size_t)(row0 + t) * NZ + ZC_GQ + h * 64 + d0), kw = *(const u32x4*)(P.Z + (size_t)(row0 + t) * NZ + ZC_GK + h * 64 + d0);
      const float qv[8] = {bflo(qw.x), bfhi(qw.x), bflo(qw.y), bfhi(qw.y), bflo(qw.z), bfhi(qw.z), bflo(qw.w), bfhi(qw.w)};
      const float kv[8] = {bflo(kw.x), bfhi(kw.x), bflo(kw.y), bfhi(kw.y), bflo(kw.z), bfhi(kw.z), bflo(kw.w), bfhi(kw.w)};
      float qo[8], ko[8];
#pragma unroll
      for (int j = 0; j < 8; ++j) { const float bb = G[t * 65 + d0 + j]; qo[j] = qv[j] * 0.125f * __expf(bb); ko[j] = kv[j] * __expf(-bb); }
      u32x4 w; w.x = pk2(qo[0], qo[1]); w.y = pk2(qo[2], qo[3]); w.z = pk2(qo[4], qo[5]); w.w = pk2(qo[6], qo[7]);
      *(LAS u32x4*)(lds + L_A + t * P72 + d0 * 2) = w;
      w.x = pk2(ko[0], ko[1]); w.y = pk2(ko[2], ko[3]); w.z = pk2(ko[4], ko[5]); w.w = pk2(ko[6], ko[7]);
      *(LAS u32x4*)(lds + L_B + t * P72 + d0 * 2) = w;
      const int v0 = (tid & 7) * 16;
      const bf16* vp = P.Z + (size_t)(row0 + t) * NZ + ZC_GV + h * 128 + v0;
      *(LAS u32x4*)(lds + L_V + t * P136 + v0 * 2) = *(const u32x4*)vp; *(LAS u32x4*)(lds + L_V + t * P136 + v0 * 2 + 16) = *(const u32x4*)(vp + 8);
      const bf16* sp = P.GS + ((size_t)unit * 64 + t) * 128 + v0;
      *(LAS u32x4*)(lds + L_ST + t * P136 + v0 * 2) = *(const u32x4*)sp; *(LAS u32x4*)(lds + L_ST + t * P136 + v0 * 2 + 16) = *(const u32x4*)(sp + 8); }
    WG_SYNC();
    const int mb = wid & 3, tq = 16 * mb + (lane & 15);
#pragma unroll
    for (int i = 0; i < 2; ++i) { const int nb = 2 * (wid >> 2) + i; f32x4 acc = {0.f, 0.f, 0.f, 0.f};
        mm16<false, false, 64>(acc, lds + L_A, P72, 16 * mb, lds + L_B, P72, 16 * nb, lane);
#pragma unroll
        for (int r = 0; r < 4; ++r) if (16 * nb + 4 * (lane >> 4) + r > tq) acc[r] = 0.f;
        *(LAS u32x2*)(lds + L_SM + tq * P72 + (16 * nb + 4 * (lane >> 4)) * 2) = pack4(acc); }
    WG_SYNC();
    f32x4 acc[4]; float ssq = 0.f;
#pragma unroll
    for (int i = 0; i < 4; ++i) { const int nb = 4 * (wid >> 2) + i; acc[i] = (f32x4){0.f, 0.f, 0.f, 0.f};
        mm16<false, true, 64>(acc[i], lds + L_SM, P72, 16 * mb, lds + L_V, P136, 16 * nb, lane);
        mm16<false, true, 64>(acc[i], lds + L_A, P72, 16 * mb, lds + L_ST, P136, 16 * nb, lane);
        ssq += (acc[i][0] * acc[i][0] + acc[i][1] * acc[i][1]) + (acc[i][2] * acc[i][2] + acc[i][3] * acc[i][3]); }
    ssq = add_x16_x32(ssq);
    LAS float* PART = (LAS float*)(lds + L_PART);
    if ((lane >> 4) == 0) PART[tq * 2 + (wid >> 2)] = ssq;
    WG_SYNC();
    const float rs = rsqrtf((PART[tq * 2] + PART[tq * 2 + 1]) * (1.f / 128.f) + EPSN);
#pragma unroll
    for (int i = 0; i < 4; ++i) { const int v = 16 * (4 * (wid >> 2) + i) + 4 * (lane >> 4);
        const f32x4 gn = *(const f32x4*)(P.gnorm + v);
        const f32x4 gg = unpack4(*(const u32x2*)(P.Z + (size_t)(row0 + tq) * NZ + ZC_GG + h * 128 + v));
        f32x4 o;
#pragma unroll
        for (int r = 0; r < 4; ++r) o[r] = acc[i][r] * rs * gn[r] * silu_f(gg[r]);
        *(u32x2*)(P.OABC + (size_t)(row0 + tq) * 1536 + 512 + h * 128 + v) = pack4(o); }
    WG_SYNC();
}
}
namespace rwkv {
constexpr int P72 = 144, PSG = 336;
constexpr int A_TW = 0, A_XA = 9216, A_WD = 18432, A_WI = 27648;
constexpr int A_SG = 0, A_WG = 21504;
constexpr int A_G = 0;
constexpr int A_PP = 0, A_ARK = 9216, A_NARB = 18432, A_MM = 27648  , A_WM = 27648, A_UV = 36864, A_XF = 46080  ;
constexpr int S_KQ = 79872, S_KD = S_KQ + 9216, S_BD = S_KD + 9216, S_KE = S_BD + 9216, S_NBE = S_KE + 9216, S_RD = S_NBE + 9216, S_VV = S_RD + 9216;
constexpr int L_RED = S_VV + 9216  , L_BON = L_RED + 512  , L_EGC = L_BON + 512  , L_END = L_EGC + 256;
static_assert(L_END <= 150 * 1024, "rwkv LDS map");
struct Ptrs { const bf16* Z; const float *mu, *w0, *w_decay, *a0, *w_iclr, *w_gate, *k_k, *k_a, *r_k, *ln_w, *ln_b;
              bf16* RA; float* RB; bf16* RQ; float* RY0; bf16* RSC; bf16* E1; bf16* E2; bf16* OABC; };

__device__ __forceinline__ f32x4 ld4bf(const bf16* p) { return unpack4(*(const u32x2*)p); }
__device__ __forceinline__ f32x4 lerp4(const bf16* Z, size_t row, bool has_prev, int col, const float* mu) {
    const f32x4 z = ld4bf(Z + row * NZ + col); f32x4 zp = {0.f, 0.f, 0.f, 0.f};
    if (has_prev) zp = ld4bf(Z + (row - 1) * NZ + col);
    const f32x4 m = *(const f32x4*)mu;
    return z + m * (zp - z);
}
__device__ __forceinline__ void rw1_unit(const int w0, const Ptrs& P, LAS unsigned char* lds, int unit) {
    const int tid = lt_tid(w0), lane = tid & 63, wid = __builtin_amdgcn_readfirstlane(tid >> 6);
    const int h = unit & 7, bc = unit >> 3, c = bc & 127, row0 = (bc >> 7) * SEQ + c * 64;
    const int mb = wid & 3, nbp = wid >> 2, fr = lane & 15, fq = lane >> 4;
    const int t = 16 * mb + fr;
    const size_t row = (size_t)row0 + t; const bool has_prev = (c > 0) || (t > 0);
    f32x4 r_[2], k_[2], v_[2];
#pragma unroll
    for (int i = 0; i < 2; ++i) { const int j = 16 * (2 * nbp + i) + 4 * fq;
        r_[i] = lerp4(P.Z, row, has_prev, ZC_RR + h * 64 + j, P.mu + h * 64 + j);
        k_[i] = lerp4(P.Z, row, has_prev, ZC_RK + h * 64 + j, P.mu + 512 + h * 64 + j);
        v_[i] = lerp4(P.Z, row, has_prev, ZC_RV + h * 64 + j, P.mu + 1024 + h * 64 + j); }
#pragma unroll
    for (int i = 0; i < 2; ++i) { const int j = 16 * (2 * nbp + i) + 4 * fq;
        f32x4 xw = lerp4(P.Z, row, has_prev, ZC_XW + j, P.mu + 1536 + j);
#pragma unroll
        for (int q = 0; q < 4; ++q) { const float e = __expf(2.f * xw[q]); xw[q] = 1.f - 2.f / (e + 1.f); }
        *(LAS u32x2*)(lds + A_TW + t * P72 + j * 2) = pack4(xw);
        const f32x4 xa = lerp4(P.Z, row, has_prev, ZC_XA + j, P.mu + 1600 + j);
        *(LAS u32x2*)(lds + A_XA + t * P72 + j * 2) = pack4(xa); }
    { const int kr = tid >> 3, j0 = (tid & 7) * 8;
      const float* s1 = P.w_decay + (size_t)kr * 512 + h * 64 + j0; const float* s2 = P.w_iclr + (size_t)kr * 512 + h * 64 + j0;
      const f32x4 a = *(const f32x4*)s1, b = *(const f32x4*)(s1 + 4), c2 = *(const f32x4*)s2, d2 = *(const f32x4*)(s2 + 4);
      u32x4 w; w.x = pk2(a[0], a[1]); w.y = pk2(a[2], a[3]); w.z = pk2(b[0], b[1]); w.w = pk2(b[2], b[3]);
      *(LAS u32x4*)(lds + A_WD + kr * P72 + j0 * 2) = w;
      w.x = pk2(c2[0], c2[1]); w.y = pk2(c2[2], c2[3]); w.z = pk2(d2[0], d2[1]); w.w = pk2(d2[2], d2[3]);
      *(LAS u32x4*)(lds + A_WI + kr * P72 + j0 * 2) = w; }
    WG_SYNC();
    f32x4 wl[2], al[2], gg[2];
#pragma unroll
    for (int i = 0; i < 2; ++i) { const int nb = 2 * nbp + i; wl[i] = (f32x4){0.f, 0.f, 0.f, 0.f}; al[i] = (f32x4){0.f, 0.f, 0.f, 0.f}; gg[i] = (f32x4){0.f, 0.f, 0.f, 0.f};
        mm16<false, true, 64>(wl[i], lds + A_TW, P72, 16 * mb, lds + A_WD, P72, 16 * nb, lane);
        mm16<false, true, 64>(al[i], lds + A_XA, P72, 16 * mb, lds + A_WI, P72, 16 * nb, lane); }
    WG_SYNC();
    { const int tt = tid >> 3, c0 = (tid & 7) * 20; const size_t rr = (size_t)row0 + tt; const bool hp = (c > 0) || (tt > 0);
#pragma unroll
      for (int q = 0; q < 5; ++q) { f32x4 x = lerp4(P.Z, rr, hp, ZC_XG + c0 + 4 * q, P.mu + 1664 + c0 + 4 * q);
#pragma unroll
          for (int e = 0; e < 4; ++e) x[e] = sigmoid_f(x[e]);
          *(LAS u32x2*)(lds + A_SG + tt * PSG + (c0 + 4 * q) * 2) = pack4(x); } }
    for (int idx = tid; idx < 160 * 8; idx += 512) { const int kr = idx >> 3, j0 = (idx & 7) * 8;
        const float* s1 = P.w_gate + (size_t)kr * 512 + h * 64 + j0; const f32x4 a = *(const f32x4*)s1, b = *(const f32x4*)(s1 + 4);
        u32x4 w; w.x = pk2(a[0], a[1]); w.y = pk2(a[2], a[3]); w.z = pk2(b[0], b[1]); w.w = pk2(b[2], b[3]);
        *(LAS u32x4*)(lds + A_WG + kr * P72 + j0 * 2) = w; }
    WG_SYNC();
#pragma unroll
    for (int i = 0; i < 2; ++i) mm16<false, true, 160>(gg[i], lds + A_SG, PSG, 16 * mb, lds + A_WG, P72, 16 * (2 * nbp + i), lane);
    WG_SYNC();
    f32x4 lw[2], kk[2], km[2], bv[2]; float ssq = 0.f, bon = 0.f;
#pragma unroll
    for (int i = 0; i < 2; ++i) { const int j = 16 * (2 * nbp + i) + 4 * fq, cj = h * 64 + j;
        const f32x4 w0v = *(const f32x4*)(P.w0 + cj), a0v = *(const f32x4*)(P.a0 + cj), kkv = *(const f32x4*)(P.k_k + cj), kav = *(const f32x4*)(P.k_a + cj), rkv = *(const f32x4*)(P.r_k + cj);
#pragma unroll
        for (int q = 0; q < 4; ++q) {
            const float x = -(w0v[q] + wl[i][q]);
            const float sp = fmaxf(x, 0.f) + softplus_nabs(x);
            lw[i][q] = -__expf(-sp - 0.5f);
            const float a = sigmoid_f(a0v[q] + al[i][q]);
            const float kq = k_[i][q] * kkv[q];
            kk[i][q] = kq; ssq += kq * kq;
            km[i][q] = k_[i][q] * (1.f + (a - 1.f) * kav[q]);
            bv[i][q] = a;
            bon += r_[i][q] * km[i][q] * rkv[q]; } }
    ssq = add_x16_x32(ssq); bon = add_x16_x32(bon);
    LAS float* RED = (LAS float*)(lds + L_RED); LAS float* BON = (LAS float*)(lds + L_BON); LAS float* G = (LAS float*)(lds + A_G); LAS float* EGC = (LAS float*)(lds + L_EGC);
    if (fq == 0) { RED[t * 2 + nbp] = ssq; BON[t * 2 + nbp] = bon; }
#pragma unroll
    for (int i = 0; i < 2; ++i) { const int j = 16 * (2 * nbp + i) + 4 * fq;
#pragma unroll
        for (int q = 0; q < 4; ++q) G[t * 65 + j + q] = lw[i][q]; }
    WG_SYNC();
#pragma unroll
    for (int jj = 0; jj < 8; ++jj) { const int d = wid * 8 + jj; float v = G[lane * 65 + d];
#pragma unroll
        for (int off = 1; off < 64; off <<= 1) { const float n = shfl_up_l(v, lane, off); if (lane >= off) v += n; }
        G[lane * 65 + d] = v; }
    WG_SYNC();
    const float inorm = 1.f / fmaxf(sqrtf(RED[t * 2] + RED[t * 2 + 1]), 1e-12f), bonus = BON[t * 2] + BON[t * 2 + 1];
    f32x4 kqf[2], rdf[2];
#pragma unroll
    for (int i = 0; i < 2; ++i) { const int j = 16 * (2 * nbp + i) + 4 * fq;
        f32x4 kd, bd, ke, nbe;
#pragma unroll
        for (int q = 0; q < 4; ++q) {
            const float gt = G[t * 65 + j + q], gp = (t > 0) ? G[(t - 1) * 65 + j + q] : 0.f, gc = G[63 * 65 + j + q];
            const float kkn = kk[i][q] * inorm, bb = kkn * bv[i][q];
            const float eg = __expf(gt), egm = __expf(-gt), egc = __expf(gc - gt);
            kqf[i][q] = kkn * __expf(gp); rdf[i][q] = r_[i][q] * eg;
            kd[q] = km[i][q] * egm; bd[q] = bb * egm; ke[q] = km[i][q] * egc; nbe[q] = -bb * egc;
            if (t == 63) EGC[j + q] = eg; }
        const int off = t * P72 + j * 2;
        *(LAS u32x2*)(lds + S_KQ + off) = pack4(kqf[i]); *(LAS u32x2*)(lds + S_KD + off) = pack4(kd); *(LAS u32x2*)(lds + S_BD + off) = pack4(bd);
        *(LAS u32x2*)(lds + S_KE + off) = pack4(ke); *(LAS u32x2*)(lds + S_NBE + off) = pack4(nbe); *(LAS u32x2*)(lds + S_RD + off) = pack4(rdf[i]);
        *(LAS u32x2*)(lds + S_VV + off) = pack4(v_[i]);
        *(u32x2*)(P.E1 + row * 512 + h * 64 + j) = pack4(gg[i]);
        *(u32x2*)(P.E2 + row * 512 + h * 64 + j) = pack4(v_[i] * bonus); }
    WG_SYNC();
#pragma unroll
    for (int i = 0; i < 2; ++i) { const int nb = 2 * nbp + i, s0 = 16 * nb + 4 * fq;
        f32x4 pp = {0.f, 0.f, 0.f, 0.f}, mmv = pp, ark = pp, arb = pp;
        mm16<false, false, 64>(pp, lds + S_KQ, P72, 16 * mb, lds + S_KD, P72, 16 * nb, lane);
        mm16<false, false, 64>(mmv, lds + S_KQ, P72, 16 * mb, lds + S_BD, P72, 16 * nb, lane);
        mm16<false, false, 64>(ark, lds + S_RD, P72, 16 * mb, lds + S_KD, P72, 16 * nb, lane);
        mm16<false, false, 64>(arb, lds + S_RD, P72, 16 * mb, lds + S_BD, P72, 16 * nb, lane);
#pragma unroll
        for (int q = 0; q < 4; ++q) { const int s = s0 + q; if (s >= t) { pp[q] = 0.f; mmv[q] = 0.f; } if (s > t) { ark[q] = 0.f; arb[q] = 0.f; } arb[q] = -arb[q]; }
        *(LAS u32x2*)(lds + A_PP + t * P72 + s0 * 2) = pack4(pp); *(LAS u32x2*)(lds + A_ARK + t * P72 + s0 * 2) = pack4(ark); *(LAS u32x2*)(lds + A_NARB + t * P72 + s0 * 2) = pack4(arb);
        *(LAS f32x4*)(lds + A_MM + (t * 68 + s0) * 4) = mmv; }
    WG_SYNC();
#pragma unroll
    for (int i = 0; i < 2; ++i) { const int nb = 2 * nbp + i, j = 16 * nb + 4 * fq; f32x4 pv = {0.f, 0.f, 0.f, 0.f};
        mm16<false, true, 64>(pv, lds + A_PP, P72, 16 * mb, lds + S_VV, P72, 16 * nb, lane);
        *(LAS f32x4*)(lds + A_XF + (t * 132 + j) * 4) = kqf[i]; *(LAS f32x4*)(lds + A_XF + (t * 132 + 64 + j) * 4) = pv; }
    WG_SYNC();
    if (tid < 128) {
        float x[64];
#pragma unroll
        for (int tt = 0; tt < 64; ++tt) {
            float a = *(const LAS float*)(lds + A_XF + (tt * 132 + tid) * 4);
#pragma unroll
            for (int s4 = 0; s4 < tt; s4 += 4) { const f32x4 mv = *(const LAS f32x4*)(lds + A_MM + (tt * 68 + s4) * 4);
#pragma unroll
                for (int e = 0; e < 4; ++e) if (s4 + e < tt) a -= mv[e] * x[s4 + e]; }
            x[tt] = a;
            *(LAS float*)(lds + A_XF + (tt * 132 + tid) * 4) = a; }
    }
    WG_SYNC();
    { f32x4 wmv[2], uvv[2];
#pragma unroll
      for (int i = 0; i < 2; ++i) { const int j = 16 * (2 * nbp + i) + 4 * fq; wmv[i] = *(const LAS f32x4*)(lds + A_XF + (t * 132 + j) * 4); uvv[i] = *(const LAS f32x4*)(lds + A_XF + (t * 132 + 64 + j) * 4); }
#pragma unroll
      for (int i = 0; i < 2; ++i) { const int j = 16 * (2 * nbp + i) + 4 * fq;
          *(LAS u32x2*)(lds + A_WM + t * P72 + j * 2) = pack4(wmv[i]); *(LAS u32x2*)(lds + A_UV + t * P72 + j * 2) = pack4(uvv[i]); } }
    WG_SYNC();
    const size_t ub = (size_t)unit * 4096;
#pragma unroll
    for (int i = 0; i < 2; ++i) { const int nb = 2 * nbp + i, n0 = 16 * nb + 4 * fq, mrow = 16 * mb + fr;
        f32x4 at, bc2 = {0.f, 0.f, 0.f, 0.f}, rq = rdf[i], y0 = {0.f, 0.f, 0.f, 0.f};
#pragma unroll
        for (int q = 0; q < 4; ++q) at[q] = (n0 + q == mrow) ? EGC[mrow] : 0.f;
        mm16<true, true, 64>(at, lds + S_NBE, P72, 16 * mb, lds + A_WM, P72, 16 * nb, lane);
        mm16<true, true, 64>(bc2, lds + S_VV, P72, 16 * mb, lds + S_KE, P72, 16 * nb, lane);
        mm16<true, true, 64>(bc2, lds + A_UV, P72, 16 * mb, lds + S_NBE, P72, 16 * nb, lane);
        mm16<false, true, 64>(rq, lds + A_NARB, P72, 16 * mb, lds + A_WM, P72, 16 * nb, lane);
        mm16<false, true, 64>(y0, lds + A_ARK, P72, 16 * mb, lds + S_VV, P72, 16 * nb, lane);
        mm16<false, true, 64>(y0, lds + A_NARB, P72, 16 * mb, lds + A_UV, P72, 16 * nb, lane);
        *(u32x2*)(P.RA + ub + mrow * 64 + n0) = pack4(at); *(f32x4*)(P.RB + ub + mrow * 64 + n0) = bc2;
        *(u32x2*)(P.RQ + ub + mrow * 64 + n0) = pack4(rq); *(f32x4*)(P.RY0 + ub + mrow * 64 + n0) = y0; }
    WG_SYNC();
}
__device__ __forceinline__ void rw2_chain(const int w0, const Ptrs& P, LAS unsigned char* lds, int chain) {
    const int tid = lt_tid(w0), lane = tid & 63, wid = __builtin_amdgcn_readfirstlane(tid >> 6);
    const int b = chain >> 3, h = chain & 7, mb = wid & 3, nbp = wid >> 2, fr = lane & 15, fq = lane >> 4, mrow = 16 * mb + fr;
    f32x4 S[2] = {{0.f, 0.f, 0.f, 0.f}, {0.f, 0.f, 0.f, 0.f}};
    for (int c = 0; c < 128; ++c) {
        const size_t ub = ((size_t)(b * 128 + c) * 8 + h) * 4096;
        LAS unsigned char* sl = lds + (c & 1) * 9216;
        bf16x8 af[2][2]; f32x4 bb[2];
#pragma unroll
        for (int i = 0; i < 2; ++i) { const int nb = 2 * nbp + i, n0 = 16 * nb + 4 * fq;
            af[i][0] = gfrag(P.RA + ub, 64, 16 * nb, 0, lane); af[i][1] = gfrag(P.RA + ub, 64, 16 * nb, 32, lane);
            bb[i] = *(const f32x4*)(P.RB + ub + mrow * 64 + n0);
            const u32x2 w = pack4(S[i]);
            *(u32x2*)(P.RSC + ub + mrow * 64 + n0) = w; *(LAS u32x2*)(sl + mrow * P72 + n0 * 2) = w; }
        WG_SYNC();
#pragma unroll
        for (int i = 0; i < 2; ++i) { f32x4 acc = bb[i];
#pragma unroll
            for (int ks = 0; ks < 2; ++ks) acc = __builtin_amdgcn_mfma_f32_16x16x32_bf16(af[i][ks], ldfrag<false>(sl, P72, 16 * mb, 32 * ks, lane), acc, 0, 0, 0);
            S[i] = acc; }
    }
    WG_SYNC();
}
__device__ __forceinline__ void rw3_unit(const int w0, const Ptrs& P, int unit) {
    const int lane = lt_tid(w0) & 63, fr = lane & 15, fq = lane >> 4;
    const int h = unit & 7, bc = unit >> 3, row0 = (bc >> 7) * SEQ + (bc & 127) * 64;
    const size_t ub = (size_t)unit * 4096;
    bf16x8 sf[4][2];
#pragma unroll
    for (int nb = 0; nb < 4; ++nb) { sf[nb][0] = gfrag(P.RSC + ub, 64, 16 * nb, 0, lane); sf[nb][1] = gfrag(P.RSC + ub, 64, 16 * nb, 32, lane); }
#pragma unroll
    for (int mb = 0; mb < 4; ++mb) {
        const bf16x8 q0 = gfrag(P.RQ + ub, 64, 16 * mb, 0, lane), q1 = gfrag(P.RQ + ub, 64, 16 * mb, 32, lane);
        const int t = 16 * mb + fr; const size_t row = (size_t)row0 + t;
        f32x4 y[4]; float s = 0.f;
#pragma unroll
        for (int nb = 0; nb < 4; ++nb) { y[nb] = *(const f32x4*)(P.RY0 + ub + t * 64 + 16 * nb + 4 * fq);
            y[nb] = __builtin_amdgcn_mfma_f32_16x16x32_bf16(sf[nb][0], q0, y[nb], 0, 0, 0); y[nb] = __builtin_amdgcn_mfma_f32_16x16x32_bf16(sf[nb][1], q1, y[nb], 0, 0, 0);
            s += (y[nb][0] + y[nb][1]) + (y[nb][2] + y[nb][3]); }
        s = add_x16_x32(s);
        const float mean = s * (1.f / 64.f); float v2 = 0.f;
#pragma unroll
        for (int nb = 0; nb < 4; ++nb) { y[nb] = y[nb] - mean; v2 += (y[nb][0] * y[nb][0] + y[nb][1] * y[nb][1]) + (y[nb][2] * y[nb][2] + y[nb][3] * y[nb][3]); }
        v2 = add_x16_x32(v2);
        const float rstd = rsqrtf(v2 * (1.f / 64.f) + 64e-5f);
#pragma unroll
        for (int nb = 0; nb < 4; ++nb) { const int i0 = 16 * nb + 4 * fq, ci = h * 64 + i0;
            const f32x4 lw = *(const f32x4*)(P.ln_w + ci), lb = *(const f32x4*)(P.ln_b + ci), e1 = ld4bf(P.E1 + row * 512 + ci), e2 = ld4bf(P.E2 + row * 512 + ci);
            const f32x4 o = (y[nb] * rstd * lw + lb + e2) * e1;
            *(u32x2*)(P.OABC + row * 1536 + 1024 + ci) = pack4(o); }
    }
}
}
struct Frame {
    LAS unsigned char* lds; gu32* ctl; unsigned char* ws;
    int tid, lane, wave, vcu, G;
    float* x;
};
__device__ __forceinline__ int zmap(int n) {
    if (n < 416) return n;
    if (n < 432) return 1952 + (n - 416);
    if (n < 496) return 3504 + (n - 432);
    if (n < 512) return -1;
    if (n < 768) return 416 + (n - 512);
    if (n < 1024) return 672 + (n - 768);
    if (n < 1536) return 928 + (n - 1024);
    if (n < 2048) return 1440 + (n - 1536);
    if (n < 3584) return 1968 + (n - 2048);
    if (n < 3648) return 3568 + (n - 3584);
    if (n < 3808) return 3632 + (n - 3648);
    if (n < 3840) return -1;
    return 3792 + (n - 3840);
}
struct MapId { __device__ __forceinline__ int operator()(int n) const { return n; } };
struct MapSwiglu { __device__ __forceinline__ int operator()(int n) const { const int tile = n >> 8, j = n & 255; return j < 128 ? 128 * tile + j : DFF + 128 * tile + (j - 128); } };
struct MapZ { __device__ __forceinline__ int operator()(int n) const { return zmap(n); } };
template <class Map> __device__ __forceinline__ void conv_matrix(Frame& F, const float* W, int K, int Nsrc, bf16* WT, int Ndst, int ldk, const float* kscale, Map map) {
    LAS float* scr = (LAS float*)(F.lds + RING_OFF + F.wave * 16384);
    const int gw = F.vcu * NWAVES + F.wave, NGW = F.G * NWAVES, nblk = Ndst / 32, items = (K / 64) * nblk, lane = F.lane;
    for (int it = gw; it < items; it += NGW) {
        const int kb = it / nblk, nb = it % nblk, k0 = 64 * kb, n0 = 32 * nb;
        const int sc = map(n0 + (lane & 31));
#pragma unroll 8
        for (int i = 0; i < 32; ++i) { const int kk = 2 * i + (lane >> 5); float v = 0.f;
            if (sc >= 0) { v = W[(size_t)(k0 + kk) * Nsrc + sc]; if (kscale) v *= kscale[k0 + kk]; }
            scr[kk * 33 + (lane & 31)] = v; }
        LDS_WAIT(); asm volatile("" ::: "memory");
        const int c = lane & 7;
#pragma unroll
        for (int j = 0; j < 4; ++j) { const int n = (lane >> 3) + 8 * j; const LAS float* s = scr + (8 * c) * 33 + n;
            v4u o; o.x = pk2(s[0 * 33], s[1 * 33]); o.y = pk2(s[2 * 33], s[3 * 33]); o.z = pk2(s[4 * 33], s[5 * 33]); o.w = pk2(s[6 * 33], s[7 * 33]);
            *(GAS v4u*)(WT + (size_t)(n0 + n) * ldk + k0 + 8 * c) = o; }
        LDS_WAIT(); asm volatile("" ::: "memory");
    }
}
struct In {
    const float *x, *mem; const int* pos; const float *norm_g, *w_ffn_in, *w_ffn_out, *w_in, *mla_q_norm, *mla_w_uq, *mla_kv_norm, *mla_w_ukv, *gla_w_alpha, *gla_b_alpha, *gla_norm,
        *rwkv_mu, *rwkv_w0, *rwkv_w_decay, *rwkv_a0, *rwkv_w_iclr, *rwkv_w_gate, *rwkv_k_k, *rwkv_k_a, *rwkv_r_k, *rwkv_ln_w, *rwkv_ln_b, *w_branch, *w_out, *mem_norm, *mem_wq, *mem_wkv, *mem_wo;
};
__device__ __forceinline__ float row_ssq(const f32x4 (&v)[4]) { float s = 0.f;
#pragma unroll
    for (int j = 0; j < 4; ++j) s += (v[j][0] * v[j][0] + v[j][1] * v[j][1]) + (v[j][2] * v[j][2] + v[j][3] * v[j][3]);
    return wave_sum(s); }
__device__ __forceinline__ void store_row_bf16(bf16* orow, const f32x4 (&v)[4], float rs, const f32x4 (&g)[4], int lane) {
    GAS unsigned long long* o8 = (GAS unsigned long long*)orow + lane;
#pragma unroll
    for (int j = 0; j < 4; ++j) o8[64 * j] = (unsigned long long)pk2(v[j][0] * rs * g[j][0], v[j][1] * rs * g[j][1]) | ((unsigned long long)pk2(v[j][2] * rs * g[j][2], v[j][3] * rs * g[j][3]) << 32);
}
__device__ __forceinline__ void norm_phase(Frame& F, const float* xin, const float* Y, float alpha, const float* g_post, const float* g_pre, bf16* XN) {
    const int gw = F.vcu * NWAVES + F.wave, NGW = F.G * NWAVES, lane = F.lane;
    f32x4 gp[4], gq[4];
#pragma unroll
    for (int j = 0; j < 4; ++j) { gp[j] = Y ? *(const f32x4*)(g_post + 4 * lane + 256 * j) : (f32x4){0.f, 0.f, 0.f, 0.f}; gq[j] = g_pre ? *(const f32x4*)(g_pre + 4 * lane + 256 * j) : (f32x4){0.f, 0.f, 0.f, 0.f}; }
    for (int m = gw; m < M; m += NGW) {
        f32x4 xv[4];
        const float* xr = (Y ? F.x : xin) + (size_t)m * D;
#pragma unroll
        for (int j = 0; j < 4; ++j) xv[j] = *(const f32x4*)(xr + 4 * lane + 256 * j);
        if (Y) { f32x4 yv[4];
#pragma unroll
            for (int j = 0; j < 4; ++j) yv[j] = *(const f32x4*)(Y + (size_t)m * D + 4 * lane + 256 * j);
            const float rs = rsqrtf(row_ssq(yv) * (1.f / D) + EPSN) * alpha;
#pragma unroll
            for (int j = 0; j < 4; ++j) xv[j] += yv[j] * rs * gp[j]; }
#pragma unroll
        for (int j = 0; j < 4; ++j) *(f32x4*)(F.x + (size_t)m * D + 4 * lane + 256 * j) = xv[j];
        if (g_pre) { const float rs2 = rsqrtf(row_ssq(xv) * (1.f / D) + EPSN); store_row_bf16(XN + (size_t)m * D, xv, rs2, gq, lane); }
    }
}
__device__ __forceinline__ void rope_table(Frame& F, const int* pos, float* CS) {
    const double inv_freq[16] = {1.0, 0.5623413251903491, 0.31622776601683794, 0.1778279410038923, 0.1, 0.05623413251903491, 0.031622776601683794, 0.01778279410038923,
                                 0.01, 0.005623413251903491, 0.0031622776601683794, 0.001778279410038923, 0.001, 0.0005623413251903491, 0.00031622776601683794, 0.0001778279410038923};
    for (int idx = F.vcu * 512 + F.tid; idx < M * 16; idx += F.G * 512) { const int i = idx & 15, r = idx >> 4;
        double dinv = inv_freq[0];
#pragma unroll
        for (int q = 1; q < 16; ++q) dinv = (i == q) ? inv_freq[q] : dinv;
        const double rev = (double)pos[r] * dinv * 0.15915494309189535;
        const float fr = (float)(rev - floor(rev));
        CS[idx * 2] = __builtin_amdgcn_cosf(fr); CS[idx * 2 + 1] = __builtin_amdgcn_sinf(fr); }
}
__device__ __forceinline__ const float* ldptr(const LAS unsigned long long* PT, int k) { const unsigned long long v = PT[k];
    const unsigned lo = __builtin_amdgcn_readfirstlane((unsigned)v), hi = __builtin_amdgcn_readfirstlane((unsigned)(v >> 32)); return (const float*)(((unsigned long long)hi << 32) | lo); }
#define PHASE_PTRS F.tid = lt_tid(w0); F.lane = F.tid & 63; F.wave = __builtin_amdgcn_readfirstlane(F.tid >> 6); unsigned char* ws = args.ws; asm volatile("" : "+s"(ws)); F.x = args.out; asm volatile("" : "+s"(F.x)); \
            bf16* W = (bf16*)(ws + WS_W); bf16* XN = (bf16*)(ws + WS_XN); float* Y = (float*)(ws + WS_Y); bf16* Z = (bf16*)(ws + WS_ZH); bf16* H = (bf16*)(ws + WS_ZH); \
            bf16* Qm = (bf16*)(ws + WS_Q); bf16* Km = (bf16*)(ws + WS_K); bf16* Vm = (bf16*)(ws + WS_V); bf16* OABC = (bf16*)(ws + WS_OABC); bf16* MQ = (bf16*)(ws + WS_Q); bf16* MO = (bf16*)(ws + WS_OABC); \
            float* RS = (float*)(ws + WS_RS); float* CS = (float*)(ws + WS_CS); bf16* MEMN = (bf16*)(ws + WS_MEMN); bf16* MEMKV = (bf16*)(ws + WS_MEMKV); \
            (void)W; (void)XN; (void)Y; (void)Z; (void)H; (void)Qm; (void)Km; (void)Vm; (void)OABC; (void)MQ; (void)MO; (void)RS; (void)CS; (void)MEMN; (void)MEMKV;
__device__ __forceinline__ bool ph_in(int lo, int hi, int k) { asm volatile("" : "+s"(lo), "+s"(hi)); return lo <= k && k < hi; }
struct Args { const void* in[31]; float* out; unsigned char* ws; int s_lo, s_hi, ph_lo, ph_hi, use_bar, pad; };

__global__ void __launch_bounds__(NWAVES * 64, 2) mk_fwd(Args args) {
    extern __shared__ __attribute__((aligned(16))) unsigned char lds_raw[];
    Frame F;
    F.lds = (LAS unsigned char*)lds_raw; F.ws = args.ws; F.ctl = (gu32*)(args.ws + WS_CTL);
    int w0 = __builtin_amdgcn_readfirstlane((int)threadIdx.x >> 6); asm volatile("" : "+s"(w0));
    F.tid = lt_tid(w0); F.lane = F.tid & 63; F.wave = w0;
    F.G = gridDim.x; { const int bx = blockIdx.x; F.vcu = (F.G % 8 == 0) ? (bx % 8) * (F.G / 8) + bx / 8 : bx; }
    F.x = nullptr;
    for (int u = F.tid; u < (LDS_BYTES - MISC_OFF) / 4; u += NWAVES * 64) ((LAS unsigned*)(F.lds + MISC_OFF))[u] = 0u;
    __syncthreads();
    LAS unsigned long long* PT = (LAS unsigned long long*)(F.lds + MISC_OFF + 256);
    if (F.tid == 0) {
#pragma unroll
        for (int k = 0; k < 31; ++k) PT[k] = (unsigned long long)args.in[k]; }
    __syncthreads();
    XcdBarrier bar; bar.bar = (unsigned*)(F.ctl + CW_BAR); bar.x = 0; bar.st = nullptr;
    if (args.use_bar) bar = xcd_barrier_post((unsigned*)(F.ctl + CW_BAR), (volatile LAS unsigned*)(F.lds + MISC_OFF) + 8);
#define GRID_BAR() do { if (args.use_bar) { XcdBarrier b2_ = bar; asm volatile("" : "+s"(b2_.bar)); xcd_barrier(b2_); } } while (0)
#define PH(k) ph_in(args.ph_lo, args.ph_hi, (k))
    for (int s = args.s_lo; s < args.s_hi; ++s) {
        const int l = s >> 1, f = s & 1;
#define NG (ldptr(PT, 3) + (size_t)l * 8 * D)
        if (f == 0 && PH(0)) { PHASE_PTRS

            for (int ff = 0; ff < 2; ++ff) {
                conv_matrix(F, ldptr(PT, 4) + ((size_t)l * 2 + ff) * D * 2 * DFF, D, 2 * DFF, W + (ff ? W_FFN_IN1 : W_FFN_IN0), 2 * DFF, D, nullptr, MapSwiglu());
                conv_matrix(F, ldptr(PT, 5) + ((size_t)l * 2 + ff) * DFF * D, DFF, D, W + (ff ? W_FFN_OUT1 : W_FFN_OUT0), D, DFF, nullptr, MapId());
            }
            conv_matrix(F, ldptr(PT, 6) + (size_t)l * D * DIN_SRC, D, DIN_SRC, W + W_IN, NZ, D, nullptr, MapZ());
            conv_matrix(F, ldptr(PT, 8) + (size_t)l * 256 * 768, 256, 768, W + W_UQ, 768, 256, ldptr(PT, 7) + l * 256, MapId());
            conv_matrix(F, ldptr(PT, 10) + (size_t)l * 128 * 1024, 128, 1024, W + W_UKV, 1024, 128, ldptr(PT, 9) + l * 128, MapId());
            for (int bi = 0; bi < 3; ++bi) conv_matrix(F, ldptr(PT, 25) + ((size_t)l * 1536 + bi * 512) * D, 512, D, W + W_BR + (size_t)bi * 512 * D, D, 512, nullptr, MapId());
            conv_matrix(F, ldptr(PT, 26) + (size_t)l * D * D, D, D, W + W_OUT, D, D, nullptr, MapId());
            conv_matrix(F, ldptr(PT, 28) + (size_t)l * D * D, D, D, W + W_MQ, D, D, nullptr, MapId());
            conv_matrix(F, ldptr(PT, 29) + (size_t)l * D * 2 * D, D, 2 * D, W + W_MKV, 2 * D, D, nullptr, MapId());
            conv_matrix(F, ldptr(PT, 30) + (size_t)l * D * D, D, D, W + W_MO, D, D, nullptr, MapId());
            { f32x4 gq[4];
#pragma unroll
              for (int j = 0; j < 4; ++j) gq[j] = *(const f32x4*)(ldptr(PT, 27) + (size_t)l * D + 4 * F.lane + 256 * j);
              for (int m = F.vcu * NWAVES + F.wave; m < 512; m += F.G * NWAVES) { f32x4 v[4];
#pragma unroll
                  for (int j = 0; j < 4; ++j) v[j] = *(const f32x4*)(ldptr(PT, 1) + (size_t)m * D + 4 * F.lane + 256 * j);
                  store_row_bf16(MEMN + (size_t)m * D, v, rsqrtf(row_ssq(v) * (1.f / D) + EPSN), gq, F.lane); } }
            if (l == 0) { rope_table(F, (const int*)ldptr(PT, 2), CS); norm_phase(F, ldptr(PT, 0), nullptr, 0.f, nullptr, NG, XN); }
            GRID_BAR();
        }
        if (PH(1)) { PHASE_PTRS

            { pg8::Gemm g{XN, W + (f ? W_FFN_IN1 : W_FFN_IN0), M, 2 * DFF, D, D, D}; pg8::StaticOrder S; S.init(M, 2 * DFF, F.G, (int)blockIdx.x);
              EpiSwiglu E{ws};
#ifndef SKIP_G1
pg8::gemm_phase<EpiSwiglu, pg8::StaticOrder, true, true>(w0, F.lds + RING_OFF, g, S, E);
#endif
 }
            if (f == 0) { pg8::Gemm g{MEMN, W + W_MKV, 512, 2 * D, D, D, D}; pg8::StaticOrder S; S.init(512, 2 * D, F.G, (int)blockIdx.x);
              EpiBf16S<0> E{ws};
#ifndef SKIP_G2
pg8::gemm_phase<EpiBf16S<0>, pg8::StaticOrder, true, true>(w0, F.lds + RING_OFF, g, S, E);
#endif
 }
            GRID_BAR();
        }
        if (PH(2)) { PHASE_PTRS

            pg8::Gemm g{H, W + (f ? W_FFN_OUT1 : W_FFN_OUT0), M, D, DFF, DFF, DFF}; pg8::StaticOrder S; S.init(M, D, F.G, (int)blockIdx.x);
            EpiF32 E{ws};
#ifndef SKIP_G3
pg8::gemm_phase<EpiF32, pg8::StaticOrder, true, true>(w0, F.lds + RING_OFF, g, S, E);
#endif

            GRID_BAR();
        }
        if (PH(3)) { PHASE_PTRS

            const float* g_pre = (f == 0) ? NG + 2 * D : (l < 3 ? NG + 8 * D : nullptr);
            norm_phase(F, nullptr, Y, 0.5f, NG + (f ? 7 : 1) * D, g_pre, XN);
            GRID_BAR();
        }
        if (f == 0) {
            if (PH(4)) { PHASE_PTRS

                pg8::Gemm g{XN, W + W_IN, M, NZ, D, D, D}; pg8::StaticOrder S; S.init(M, NZ, F.G, (int)blockIdx.x);
                EpiZ E{ws};
#ifndef SKIP_G4
pg8::gemm_phase<EpiZ, pg8::StaticOrder, true, true>(w0, F.lds + RING_OFF, g, S, E);
#endif

                GRID_BAR();
            }
            if (PH(5)) { PHASE_PTRS

                { pg8::Gemm g{Z + ZC_CQ, W + W_UQ, M, 768, 256, NZ, 256}; pg8::StaticOrder S; S.init(M, 768, F.G, (int)blockIdx.x);
                  EpiQ E{ws};
#ifndef SKIP_G5
pg8::gemm_phase<EpiQ, pg8::StaticOrder, true, true>(w0, F.lds + RING_OFF, g, S, E);
#endif
 }
                { pg8::Gemm g{Z + ZC_CKV, W + W_UKV, M, 1024, 128, NZ, 128}; pg8::StaticOrder S; S.init(M, 1024, F.G, (int)blockIdx.x);
                  EpiKV E{ws};
#ifndef SKIP_G6
pg8::gemm_phase<EpiKV, pg8::StaticOrder, true, true>(w0, F.lds + RING_OFF, g, S, E);
#endif
 }
            }
            if (PH(5)) { PHASE_PTRS
                for (int idx = F.vcu * 512 + F.tid; idx < M * 16; idx += F.G * 512) { const int i = idx & 15, r = idx >> 4;
                    const float t1 = bf2f(Z[(size_t)r * NZ + ZC_KROPE + i]), t2 = bf2f(Z[(size_t)r * NZ + ZC_KROPE + 16 + i]), c = CS[idx * 2], sn = CS[idx * 2 + 1];
                    const bf16 o1 = (bf16)f2bf(t1 * c - t2 * sn), o2 = (bf16)f2bf(t1 * sn + t2 * c);
#pragma unroll
                    for (int hh = 0; hh < 8; ++hh) { Km[(size_t)r * 768 + hh * 96 + 64 + i] = o1; Km[(size_t)r * 768 + hh * 96 + 80 + i] = o2; } }
                __syncthreads();
                rwkv::Ptrs RP{Z, ldptr(PT, 14) + l * 1824, ldptr(PT, 15) + l * 512, ldptr(PT, 16) + (size_t)l * 64 * 512, ldptr(PT, 17) + l * 512, ldptr(PT, 18) + (size_t)l * 64 * 512, ldptr(PT, 19) + (size_t)l * 160 * 512,
                           ldptr(PT, 20) + l * 512, ldptr(PT, 21) + l * 512, ldptr(PT, 22) + l * 512, ldptr(PT, 23) + l * 512, ldptr(PT, 24) + l * 512,
                           (bf16*)(ws + WS_RA), (float*)(ws + WS_Y), (bf16*)(ws + WS_RQ), (float*)(ws + WS_Y + 32 * MiB), (bf16*)(ws + WS_RSC), (bf16*)(ws + WS_E1), (bf16*)(ws + WS_E2), OABC};
                gla::Ptrs GP{Z, ldptr(PT, 11) + (size_t)l * 16 * 256, ldptr(PT, 12) + l * 256, ldptr(PT, 13) + l * 128, (float*)(ws + WS_GU), (bf16*)(ws + WS_GS), (float*)(ws + WS_GDEC), OABC};
#ifndef SKIP_RW1
                for (int u = F.vcu; u < 2048; u += F.G) rwkv::rw1_unit(w0, RP, F.lds, u);
#endif
#ifndef SKIP_GL1
                for (int u = F.vcu; u < 1024; u += F.G) gla::gl1_unit(w0, GP, F.lds, u);
#endif
                GRID_BAR();
            }
            if (PH(6)) { PHASE_PTRS

                rwkv::Ptrs RP{Z, ldptr(PT, 14) + l * 1824, ldptr(PT, 15) + l * 512, ldptr(PT, 16) + (size_t)l * 64 * 512, ldptr(PT, 17) + l * 512, ldptr(PT, 18) + (size_t)l * 64 * 512, ldptr(PT, 19) + (size_t)l * 160 * 512,
                           ldptr(PT, 20) + l * 512, ldptr(PT, 21) + l * 512, ldptr(PT, 22) + l * 512, ldptr(PT, 23) + l * 512, ldptr(PT, 24) + l * 512,
                           (bf16*)(ws + WS_RA), (float*)(ws + WS_Y), (bf16*)(ws + WS_RQ), (float*)(ws + WS_Y + 32 * MiB), (bf16*)(ws + WS_RSC), (bf16*)(ws + WS_E1), (bf16*)(ws + WS_E2), OABC};
                gla::Ptrs GP{Z, ldptr(PT, 11) + (size_t)l * 16 * 256, ldptr(PT, 12) + l * 256, ldptr(PT, 13) + l * 128, (float*)(ws + WS_GU), (bf16*)(ws + WS_GS), (float*)(ws + WS_GDEC), OABC};
#ifndef SKIP_RW2
                for (int ch = F.vcu; ch < 16; ch += F.G) rwkv::rw2_chain(w0, RP, F.lds, ch);
#endif
#ifndef SKIP_GL2
                for (int it = F.G - 1 - F.vcu; it < 32; it += F.G) gla::gl2_item(w0, GP, it);
#endif
                __syncthreads();
                for (int u = F.vcu; u < 256; u += F.G) { const int bh = u >> 4, sx = u & 15, b = bh >> 3, h = bh & 7; const size_t rb = (size_t)b * SEQ;
#pragma unroll 1
                    for (int k2 = 0; k2 < 2; ++k2) { const int qb = k2 ? 31 - sx : sx;
#ifndef SKIP_MLA
                        att::attn_unit<96, 64, true, true>(w0, CS + (rb + qb * 256) * 32, Qm + (rb + qb * 256) * 768 + h * 96, 768, Km + rb * 768 + h * 96, 768, Vm + rb * 512 + h * 64, 512, OABC + (rb + qb * 256) * 1536 + h * 64, 1536, qb * 256, (qb + 1) * 4, F.lds);
#endif
 } }
                GRID_BAR();
            }
            if (PH(7)) { PHASE_PTRS

                rwkv::Ptrs RP{Z, ldptr(PT, 14) + l * 1824, ldptr(PT, 15) + l * 512, ldptr(PT, 16) + (size_t)l * 64 * 512, ldptr(PT, 17) + l * 512, ldptr(PT, 18) + (size_t)l * 64 * 512, ldptr(PT, 19) + (size_t)l * 160 * 512,
                           ldptr(PT, 20) + l * 512, ldptr(PT, 21) + l * 512, ldptr(PT, 22) + l * 512, ldptr(PT, 23) + l * 512, ldptr(PT, 24) + l * 512,
                           (bf16*)(ws + WS_RA), (float*)(ws + WS_Y), (bf16*)(ws + WS_RQ), (float*)(ws + WS_Y + 32 * MiB), (bf16*)(ws + WS_RSC), (bf16*)(ws + WS_E1), (bf16*)(ws + WS_E2), OABC};
                gla::Ptrs GP{Z, ldptr(PT, 11) + (size_t)l * 16 * 256, ldptr(PT, 12) + l * 256, ldptr(PT, 13) + l * 128, (float*)(ws + WS_GU), (bf16*)(ws + WS_GS), (float*)(ws + WS_GDEC), OABC};
#ifndef SKIP_RW3
                for (int u = F.vcu; u < 256; u += F.G) rwkv::rw3_unit(w0, RP, u * 8 + F.wave);
#endif
#ifndef SKIP_GL3
                for (int u = F.vcu; u < 1024; u += F.G) gla::gl3_unit(w0, GP, F.lds, u);
#endif
                GRID_BAR();
            }
            if (PH(8)) { PHASE_PTRS

                { pg8::Gemm g{OABC, W + W_BR, M, D, 512, 1536, 512}; pg8::StaticOrder S; S.init(M, D, F.G, (int)blockIdx.x);
                  EpiBranch<0> E{ws};
#ifndef SKIP_G7
pg8::gemm_phase<EpiBranch<0>, pg8::StaticOrder, true, true>(w0, F.lds + RING_OFF, g, S, E);
#endif
 }
                VM_WAIT(); __builtin_amdgcn_fence(__ATOMIC_ACQUIRE, "agent"); VM_WAIT(); __syncthreads();
                { pg8::Gemm g{OABC + 512, W + W_BR + (size_t)512 * D, M, D, 512, 1536, 512}; pg8::StaticOrder S; S.init(M, D, F.G, (int)blockIdx.x);
                  EpiBranch<1> E{ws};
#ifndef SKIP_G8
pg8::gemm_phase<EpiBranch<1>, pg8::StaticOrder, true, true>(w0, F.lds + RING_OFF, g, S, E);
#endif
 }
                VM_WAIT(); __builtin_amdgcn_fence(__ATOMIC_ACQUIRE, "agent"); VM_WAIT(); __syncthreads();
                { pg8::Gemm g{OABC + 1024, W + W_BR + (size_t)1024 * D, M, D, 512, 1536, 512}; pg8::StaticOrder S; S.init(M, D, F.G, (int)blockIdx.x);
                  EpiBranch<2> E{ws};
#ifndef SKIP_G9
pg8::gemm_phase<EpiBranch<2>, pg8::StaticOrder, true, true>(w0, F.lds + RING_OFF, g, S, E);
#endif
 }
                GRID_BAR();
            }
            if (PH(9)) { PHASE_PTRS

                pg8::Gemm g{XN, W + W_OUT, M, D, D, D, D}; pg8::StaticOrder S; S.init(M, D, F.G, (int)blockIdx.x);
                EpiF32 E{ws};
#ifndef SKIP_G10
pg8::gemm_phase<EpiF32, pg8::StaticOrder, true, true>(w0, F.lds + RING_OFF, g, S, E);
#endif

                GRID_BAR();
            }
            if (PH(10)) { PHASE_PTRS
 norm_phase(F, nullptr, Y, 1.0f, NG + 3 * D, NG + 4 * D, XN); GRID_BAR(); }
            if (PH(11)) { PHASE_PTRS

                pg8::Gemm g{XN, W + W_MQ, M, D, D, D, D}; pg8::StaticOrder S; S.init(M, D, F.G, (int)blockIdx.x);
                EpiBf16S<1> E{ws};
#ifndef SKIP_G11
pg8::gemm_phase<EpiBf16S<1>, pg8::StaticOrder, true, true>(w0, F.lds + RING_OFF, g, S, E);
#endif

                GRID_BAR();
            }
            if (PH(12)) { PHASE_PTRS

                for (int u = F.vcu; u < 512; u += F.G) { const int rt = u >> 3, h = (u >> 1) & 3, dvh = u & 1, b = rt >> 5;
#ifndef SKIP_MEMATT
                    att::attn_unit<256, 128, false, false>(w0, nullptr, MQ + (size_t)rt * 256 * D + h * 256, D, MEMKV + (size_t)b * 256 * 2 * D + h * 256, 2 * D, MEMKV + (size_t)b * 256 * 2 * D + D + h * 256 + dvh * 128, 2 * D,
                                                    MO + (size_t)rt * 256 * D + h * 256 + dvh * 128, D, 0, 4, F.lds);
#endif
 }
                GRID_BAR();
            }
            if (PH(13)) { PHASE_PTRS

                pg8::Gemm g{MO, W + W_MO, M, D, D, D, D}; pg8::StaticOrder S; S.init(M, D, F.G, (int)blockIdx.x);
                EpiF32 E{ws};
#ifndef SKIP_G12
pg8::gemm_phase<EpiF32, pg8::StaticOrder, true, true>(w0, F.lds + RING_OFF, g, S, E);
#endif

                GRID_BAR();
            }
            if (PH(14)) { PHASE_PTRS
 norm_phase(F, nullptr, Y, 1.0f, NG + 5 * D, NG + 6 * D, XN); GRID_BAR(); }
        }
    }
#undef PH
#undef NG
#undef GRID_BAR
}


static void launch_mk(Args a, int grid, hipStream_t stream, int s_lo, int s_hi, int ph_lo, int ph_hi, int use_bar) {
    a.s_lo = s_lo; a.s_hi = s_hi; a.ph_lo = ph_lo; a.ph_hi = ph_hi; a.use_bar = use_bar; a.pad = 0;
    hipLaunchKernelGGL(mk_fwd, dim3(grid), dim3(NWAVES * 64), LDS_BYTES, stream, a);
}

extern "C" void kernel_launch(void* const* d_in, const int* in_sizes, int n_in, void* d_out, int out_size, void* d_ws, size_t ws_size, hipStream_t stream) {
    static int grid = 0;
    if (grid == 0) {
        if (n_in != 31 || out_size != M * D || ws_size < WS_END) { fprintf(stderr, "kernel_launch: unexpected problem shape (n_in %d, out %d, ws %zu)\n", n_in, out_size, ws_size); grid = -1; return; }
        int dev = 0, cus = 0;
        if (hipGetDevice(&dev) != hipSuccess || hipDeviceGetAttribute(&cus, hipDeviceAttributeMultiprocessorCount, dev) != hipSuccess) { grid = -1; return; }
        if (hipFuncSetAttribute((const void*)mk_fwd, hipFuncAttributeMaxDynamicSharedMemorySize, LDS_BYTES) != hipSuccess) { fprintf(stderr, "kernel_launch: hipFuncSetAttribute failed\n"); grid = -1; return; }
        int per_cu = 0;
        if (hipOccupancyMaxActiveBlocksPerMultiprocessor(&per_cu, (const void*)mk_fwd, NWAVES * 64, LDS_BYTES) != hipSuccess || per_cu < 1) fprintf(stderr, "kernel_launch: occupancy query reports %d\n", per_cu);
        (void)hipGetLastError();
        grid = cus;
    }
    if (grid < 0) return;
    (void)in_sizes;
    if (hipMemsetAsync((char*)d_ws + WS_CTL, 0, CTL_ZERO_BYTES, stream) != hipSuccess) return;
    Args a{};
    for (int i = 0; i < 31; ++i) a.in[i] = d_in[i];
    a.out = (float*)d_out; a.ws = (unsigned char*)d_ws;
#if defined(MK_DEBUG)
    Dbg dbg{(float*)((unsigned*)d_ws + SIG_WORDS), stream};
    unsigned char* ws = (unsigned char*)d_ws;
    typedef unsigned short u16;
    for (int s = 0; s < 2; ++s) for (int p = (s == 0 ? 0 : 1); p < (s == 0 ? 15 : 4); ++p) {
        launch_mk(a, grid, stream, s, s + 1, p, p + 1, 0);
        if (s == 0) switch (p) {
            case 0: sig_t<u16>(dbg, 1, 0, (const u16*)(ws + WS_XN), 8192, 1024, 1024, 0, 1.f); break;
            case 1: sig_t<u16>(dbg, 1, 1, (const u16*)(ws + WS_ZH), 8192, 2816, 2816, 0, 1.f); sig_t<u16>(dbg, 1, 19, (const u16*)(ws + WS_MEMKV), 256, 2048, 2048, 0, 1.f); break;
            case 3: sig_t<float>(dbg, 1, 2, (const float*)d_out, 8192, 1024, 1024, 0, 1.f); break;
            case 4: sig_t<u16>(dbg, 1, 3, (const u16*)(ws + WS_ZH), 8192, NZ, NZ, 1, 1.f); sig_t<float>(dbg, 1, 20, (const float*)(ws + WS_RS), 8192, 8, 8, 0, 1.f); break;
            case 5: sig_t<u16>(dbg, 1, 21, (const u16*)(ws + WS_Q), 8192, 768, 768, 7, 1.f / (0.10206207261596577f * LOG2E));
                    sig_t<u16>(dbg, 1, 5, (const u16*)(ws + WS_K), 8192, 768, 768, 2, 1.f); sig_t<u16>(dbg, 1, 6, (const u16*)(ws + WS_V), 8192, 512, 512, 4, 1.f);
                    sig_t<u16>(dbg, 1, 7, (const u16*)(ws + WS_K), 8192, 768, 768, 3, 1.f); sig_t<u16>(dbg, 1, 17, (const u16*)(ws + WS_E1), 8192, 512, 512, 0, 1.f); break;
            case 6: sig_t<u16>(dbg, 1, 8, (const u16*)(ws + WS_OABC), 8192, 512, 1536, 0, 1.f); break;
            case 7: sig_t<u16>(dbg, 1, 9, (const u16*)(ws + WS_OABC) + 512, 8192, 512, 1536, 0, 1.f); sig_t<u16>(dbg, 1, 10, (const u16*)(ws + WS_OABC) + 1024, 8192, 512, 1536, 0, 1.f); break;
            case 8: sig_t<u16>(dbg, 1, 11, (const u16*)(ws + WS_XN), 8192, 1024, 1024, 0, 1.f); break;
            case 10: sig_t<float>(dbg, 1, 12, (const float*)d_out, 8192, 1024, 1024, 0, 1.f); break;
            case 11: sig_t<u16>(dbg, 1, 13, (const u16*)(ws + WS_Q), 8192, 1024, 1024, 0, 1.f / (0.0625f * LOG2E)); break;
            case 12: sig_t<u16>(dbg, 1, 14, (const u16*)(ws + WS_OABC), 8192, 1024, 1024, 0, 1.f); break;
            case 14: sig_t<float>(dbg, 1, 15, (const float*)d_out, 8192, 1024, 1024, 0, 1.f); break;
            default: break;
        }
        if (s == 1 && p == 3) sig_t<float>(dbg, 1, 16, (const float*)d_out, 8192, 1024, 1024, 0, 1.f);
    }
    hipMemcpyAsync(d_out, d_in[0], (size_t)out_size * sizeof(float), hipMemcpyDeviceToDevice, stream);
    nv::forward(d_in, (float*)d_out, (float*)((char*)d_ws + 1 * MiB), stream, &dbg);
    hipLaunchKernelGGL(k_decide, dim3(1024), dim3(256), 0, stream, dbg.sig, (float*)d_out, out_size, 2e-3f);
#elif defined(MK_MULTI)
    for (int s = 0; s < 8; ++s) for (int p = ((s & 1) ? 1 : 0); p < ((s & 1) ? 4 : 15); ++p) launch_mk(a, grid, stream, s, s + 1, p, p + 1, 0);
#else
    launch_mk(a, grid, stream, 0, 8, 0, 15, 1);
#endif
}
```

```cpp
#include <hip/hip_runtime.h>
#include <cstdio>
#include <cstdint>
#include <cmath>
#define GAS __attribute__((address_space(1)))
#define LAS __attribute__((address_space(3)))
typedef unsigned short bf16;
typedef unsigned v4u __attribute__((ext_vector_type(4)));
typedef float f32x4 __attribute__((ext_vector_type(4)));
typedef short bf16x8 __attribute__((ext_vector_type(8)));
typedef GAS unsigned gu32;
typedef GAS unsigned long long gu64;
__device__ __forceinline__ int lt_tid(int w0) { asm volatile("" : "+s"(w0)); int t = (w0 << 6) | (int)__builtin_amdgcn_mbcnt_hi(~0u, __builtin_amdgcn_mbcnt_lo(~0u, 0u)); asm volatile("" : "+v"(t)); return t; }
#define RLX_AGENT __ATOMIC_RELAXED, __HIP_MEMORY_SCOPE_AGENT
#define LDS_WAIT() asm volatile("s_waitcnt lgkmcnt(0)" ::: "memory")
#define VM_WAIT() asm volatile("s_waitcnt vmcnt(0)" ::: "memory")
__device__ __forceinline__ unsigned long long rt() { return __builtin_amdgcn_s_memrealtime(); }
__device__ __forceinline__ unsigned f2bf(float f) { unsigned u = __builtin_bit_cast(unsigned, f); return (u + 0x7fffu + ((u >> 16) & 1u)) >> 16; }
__device__ __forceinline__ unsigned pk2(float lo, float hi) { return f2bf(lo) | (f2bf(hi) << 16); }

#define XB_TMO      128
#define XB_XCNT(j)  (256  + 64 * (j))
#define XB_XSUB(j)  (1280 + 64 * (j))
#define XB_XGEN(j)  (2304 + 64 * (j))
#define XB_TOP      3328
#define XB_TOPGEN   3392
#define XCD_BAR_WORDS 3456
#define XB_SPIN_CAP (1u << 18)

__device__ __forceinline__ unsigned xb_ld(unsigned* p)              { return __hip_atomic_load(p, __ATOMIC_RELAXED, __HIP_MEMORY_SCOPE_AGENT); }
__device__ __forceinline__ unsigned xb_add(unsigned* p, unsigned v) { return __hip_atomic_fetch_add(p, v, __ATOMIC_RELAXED, __HIP_MEMORY_SCOPE_AGENT); }
__device__ __forceinline__ unsigned xb_xcc_id() { return (unsigned)__builtin_amdgcn_s_getreg((3 << 11) | 20) & 0xFu; }
#define XB_SPIN(cond, bar) do { unsigned _sp = 0; while (cond) { __builtin_amdgcn_s_sleep(1); \
    if ((++_sp & 255u) == 0u) { if (xb_ld(&(bar)[XB_TMO])) break; if (_sp > XB_SPIN_CAP) { atomicAdd(&(bar)[XB_TMO], 1u); break; } } } } while (0)

struct XcdBarrier {
    unsigned* bar; unsigned x;
    volatile LAS unsigned* st;
};

__device__ __forceinline__ XcdBarrier xcd_barrier_post(unsigned* bar, volatile LAS unsigned* st) {
    XcdBarrier b; b.bar = bar; b.x = xb_xcc_id(); b.st = st;
    if (threadIdx.x == 0) (void)xb_add(&bar[XB_XCNT(b.x)], 1u);
    return b;
}
__device__ __forceinline__ void xcd_barrier_complete(unsigned* bar, unsigned x, unsigned& nloc, unsigned& nx) {
    const unsigned G = gridDim.x * gridDim.y * gridDim.z;
    unsigned sum, cnt, mine, sp = 0u;
    for (;;) {
        sum = 0u; cnt = 0u; mine = 0u;
#pragma unroll
        for (unsigned j = 0; j < 16; ++j) { const unsigned c = xb_ld(&bar[XB_XCNT(j)]); sum += c; cnt += (c > 0u) ? 1u : 0u; }
        mine = xb_ld(&bar[XB_XCNT(x)]);
        if (sum == G) break;
        __builtin_amdgcn_s_sleep(1);
        if ((++sp & 255u) == 0u) { if (xb_ld(&bar[XB_TMO])) break; if (sp > XB_SPIN_CAP) { atomicAdd(&bar[XB_TMO], 1u); break; } }
    }
    nloc = mine > 0u ? mine : 1u; nx = cnt > 0u ? cnt : 1u;
}

__device__ __forceinline__ void xcd_barrier(const XcdBarrier& b) {
    asm volatile("s_waitcnt vmcnt(0)" ::: "memory");
    __syncthreads();
    if (threadIdx.x == 0) {
        unsigned* bar = b.bar;
        __builtin_amdgcn_s_waitcnt(0);
        unsigned nloc = b.st[0], nx = b.st[1];
        if (nloc == 0u) { xcd_barrier_complete(bar, b.x, nloc, nx); b.st[0] = nloc; b.st[1] = nx; }
        const unsigned old = xb_add(&bar[XB_XSUB(b.x)], 1u);
        const unsigned gen = old / nloc;
        if (old + 1u == (gen + 1u) * nloc) {
            __builtin_amdgcn_fence(__ATOMIC_RELEASE, "agent");
            asm volatile("s_waitcnt vmcnt(0)" ::: "memory");
            const unsigned og = xb_add(&bar[XB_TOP], 1u);
            const unsigned tg = og / nx;
            if (og + 1u == (tg + 1u) * nx) xb_add(&bar[XB_TOPGEN], 1u);
            else XB_SPIN(xb_ld(&bar[XB_TOPGEN]) == tg, bar);
            __builtin_amdgcn_fence(__ATOMIC_ACQUIRE, "agent");
            xb_add(&bar[XB_XGEN(b.x)], 1u);
            asm volatile("s_waitcnt vmcnt(0)" ::: "memory");
        } else {
            XB_SPIN(xb_ld(&bar[XB_XGEN(b.x)]) == gen, bar);
            __builtin_amdgcn_fence(__ATOMIC_ACQUIRE, "agent");
            asm volatile("s_waitcnt vmcnt(0)" ::: "memory");
        }
    }
    __syncthreads();
}
namespace pg8 {
#define PG8_LAS __attribute__((address_space(3)))
typedef unsigned short bf16_t;
typedef short bf16x8 __attribute__((ext_vector_type(8)));
typedef float f32x4 __attribute__((ext_vector_type(4)));
typedef unsigned u32x4 __attribute__((ext_vector_type(4)));
constexpr int BM = 256, BK = 64, HALF = 128, HTB = HALF * BK * 2  , STAGE_BYTES = 8 * HTB, NXCD = 8, WGM = 8;

__host__ __device__ __forceinline__ int lds_byte(int r, int c) { const int st = (r >> 4) * 2 + (c >> 5), rr = r & 15, cc = c & 31, ob = rr * 64 + cc * 2; return st * 1024 + (ob ^ (((ob >> 9) & 1) << 5)); }
__host__ __device__ __forceinline__ void stage_rc(int b, int& R, int& C) { const int st = b / 1024, sb = b % 1024, swz = sb ^ (((sb >> 9) & 1) << 5); R = (st >> 1) * 16 + swz / 64; C = (st & 1) * 32 + (swz % 64) / 2; }
__host__ __device__ __forceinline__ int perm32(int rho) { const int n = rho >> 4, i = rho & 15; return 8 * (i >> 2) + 4 * n + (i & 3); }

struct Unit { int pm, pn; };
struct Gemm { const bf16_t* A; const bf16_t* Bt; int M, N, K, lda, ldb; };

struct StaticOrder {
    int nM, nN, nwg, G, c;
    __host__ __device__ void init(int M, int N, int G_, int c_) { nM = M / BM; nN = N / BM; nwg = nM * nN; G = G_; c = c_; }
    __host__ __device__ bool next(int i, Unit& u) const {
        const long L = (long)i * G + c; if (L >= nwg) return false;
        int wgid = (int)L; { const int q = nwg / NXCD, r = nwg % NXCD, xcd = wgid % NXCD, off = wgid / NXCD; wgid = (xcd < r ? xcd * (q + 1) : r * (q + 1) + (xcd - r) * q) + off; }
        const int nig = WGM * nN, gid = wgid / nig, fm = gid * WGM, gsz = (nM - fm) < WGM ? (nM - fm) : WGM;
        u.pm = fm + ((wgid % nig) % gsz); u.pn = (wgid % nig) / gsz; return true;
    }
    __device__ __forceinline__ void a_ready(const Unit&) const {}
    __device__ __forceinline__ void done(const Unit&) const {}
};

__device__ __forceinline__ unsigned cvt_pk_bf16(float lo, float hi) { unsigned r; asm volatile("v_cvt_pk_bf16_f32 %0, %1, %2" : "=v"(r) : "v"(lo), "v"(hi)); return r; }
template <class Epi, class Sched, bool ALIGN_EPI = false, bool SP2 = false>
__device__ __forceinline__ void gemm_phase(const int w0, PG8_LAS unsigned char* lds, const Gemm g, const Sched& S, const Epi& E) {
    const int tid = lt_tid(w0), wid = __builtin_amdgcn_readfirstlane(tid >> 6), lane = tid & 63, wr = wid >> 2, wc = wid & 3, fr = lane & 15, fq = lane >> 4;
    const int K = g.K, nt = K / BK;
    unsigned voffA[2], voffB[2];
#pragma unroll
    for (int i = 0; i < 2; ++i) { int R, C; stage_rc(tid * 16 + i * 8192, R, C); const int Rb = Epi::PERM ? ((R & ~31) + perm32(R & 31)) : R;
        voffA[i] = (unsigned)(R * g.lda + C) * 2u; voffB[i] = (unsigned)(Rb * g.ldb + C) * 2u; }
    const size_t kstep = (size_t)(BK * 2);
    const size_t hstepA = (size_t)HALF * g.lda * 2, hstepB = (size_t)HALF * g.ldb * 2;
    const size_t tstepA = 2 * hstepA, tstepB = 2 * hstepB;
    const unsigned ldsw = (unsigned)wid * 1024u;
    const int aoff = lds_byte(wr * 64 + fr, fq * 8), boff = lds_byte(wc * 32 + fr, fq * 8);
#define PG8_SA(b, h) (((b) * 2 + (h)) * HTB)
#define PG8_SB(b, h) ((4 + (b) * 2 + (h)) * HTB)
#define PG8_STAGE(bufoff, gbase, voff) do { _Pragma("unroll") for (int _i = 0; _i < 2; ++_i) \
        __builtin_amdgcn_global_load_lds((const unsigned*)((const char*)(gbase) + (voff)[_i]), (PG8_LAS unsigned*)(lds + (bufoff) + ldsw + _i * 8192), 16, 0, 0); } while (0)
#define PG8_LDA(dst, b, h) do { _Pragma("unroll") for (int m = 0; m < 4; ++m) _Pragma("unroll") for (int k = 0; k < 2; ++k) dst[m][k] = *(const PG8_LAS bf16x8*)(lds + PG8_SA(b, h) + aoff + m * 2048 + k * 1024); } while (0)
#define PG8_LDB(dst, b, h) do { _Pragma("unroll") for (int n = 0; n < 2; ++n) _Pragma("unroll") for (int k = 0; k < 2; ++k) dst[n][k] = *(const PG8_LAS bf16x8*)(lds + PG8_SB(b, h) + boff + n * 2048 + k * 1024); } while (0)
#define PG8_MMA(ai, bj, At, Bt) do { __builtin_amdgcn_s_setprio(1); _Pragma("unroll") for (int m = 0; m < 4; ++m) _Pragma("unroll") for (int n = 0; n < 2; ++n) _Pragma("unroll") for (int k = 0; k < 2; ++k) \
        acc[ai][bj][m][n] = __builtin_amdgcn_mfma_f32_16x16x32_bf16(Bt[n][k], At[m][k], acc[ai][bj][m][n], 0, 0, 0); __builtin_amdgcn_s_setprio(0); } while (0)
#define PG8_WAIT_V(n) asm volatile("s_waitcnt vmcnt(" #n ")" ::: "memory")
#define PG8_WAIT_L(n) asm volatile("s_waitcnt lgkmcnt(" #n ")" ::: "memory")
#define PG8_BAR __builtin_amdgcn_s_barrier()
#define PG8_SCHED __builtin_amdgcn_sched_barrier(0)
    Unit cur, nxt; int ui = 0;
    if (!S.next(0, cur)) return;
    f32x4 acc[2][2][4][2];
#pragma unroll
    for (int a = 0; a < 2; ++a)
#pragma unroll
        for (int b = 0; b < 2; ++b)
#pragma unroll
            for (int m = 0; m < 4; ++m)
#pragma unroll
                for (int n = 0; n < 2; ++n) acc[a][b][m][n] = (f32x4){0.f, 0.f, 0.f, 0.f};
    bf16x8 At[4][2], B0[2][2], B1[2][2];
    const char* cA = (const char*)g.A + (size_t)cur.pm * tstepA; const char* cB = (const char*)g.Bt + (size_t)cur.pn * tstepB;
    S.a_ready(cur);
    if constexpr (SP2) {
        PG8_STAGE(PG8_SB(0, 0), cB, voffB); PG8_STAGE(PG8_SB(0, 1), cB + hstepB, voffB); PG8_STAGE(PG8_SA(0, 0), cA, voffA); PG8_STAGE(PG8_SA(0, 1), cA + hstepA, voffA);
        if (wr == 1) PG8_BAR;
        PG8_WAIT_V(2); PG8_BAR;
        PG8_STAGE(PG8_SB(1, 0), cB + kstep, voffB); PG8_STAGE(PG8_SA(1, 0), cA + kstep, voffA); PG8_STAGE(PG8_SB(1, 1), cB + hstepB + kstep, voffB);
        PG8_WAIT_V(6); PG8_BAR;
    } else {
        PG8_STAGE(PG8_SB(0, 0), cB, voffB); PG8_STAGE(PG8_SA(0, 0), cA, voffA); PG8_STAGE(PG8_SB(0, 1), cB + hstepB, voffB); PG8_STAGE(PG8_SA(0, 1), cA + hstepA, voffA);
        if (wr == 1) PG8_BAR;
        PG8_WAIT_V(4); PG8_BAR;
        PG8_STAGE(PG8_SB(1, 0), cB + kstep, voffB); PG8_STAGE(PG8_SA(1, 0), cA + kstep, voffA); PG8_STAGE(PG8_SB(1, 1), cB + hstepB + kstep, voffB);
        PG8_WAIT_V(6); PG8_BAR;
    }
    for (;;) {
        const bool has_next = S.next(ui + 1, nxt);
        const char* nA = has_next ? (const char*)g.A + (size_t)nxt.pm * tstepA : cA; const char* nB = has_next ? (const char*)g.Bt + (size_t)nxt.pn * tstepB : cB;
        for (int t = 0; t < nt; t += 2) {
            const bool last = (t == nt - 2);
            const char* a1 = cA + (size_t)(t + 1) * kstep;
            const char* a2 = last ? nA : cA + (size_t)(t + 2) * kstep; const char* b2 = last ? nB : cB + (size_t)(t + 2) * kstep;
            const char* a3 = a2 + kstep; const char* b3 = b2 + kstep;
            if (last && has_next) S.a_ready(nxt);
            if constexpr (SP2) {
            PG8_LDB(B0, 0, 0); PG8_LDB(B1, 0, 1); PG8_SCHED; PG8_LDA(At, 0, 0); PG8_STAGE(PG8_SA(1, 1), a1 + hstepA, voffA);
            PG8_WAIT_V(8); PG8_WAIT_L(0); PG8_BAR; PG8_MMA(0, 0, At, B0); PG8_MMA(0, 1, At, B1); PG8_BAR; PG8_SCHED;
            PG8_LDA(At, 0, 1); PG8_STAGE(PG8_SB(0, 0), b2, voffB); PG8_STAGE(PG8_SB(0, 1), b2 + hstepB, voffB); PG8_STAGE(PG8_SA(0, 0), a2, voffA);
            PG8_WAIT_V(8); PG8_WAIT_L(0); PG8_BAR; PG8_MMA(1, 0, At, B0); PG8_MMA(1, 1, At, B1); PG8_BAR; PG8_SCHED;
            PG8_LDB(B0, 1, 0); PG8_LDB(B1, 1, 1); PG8_SCHED; PG8_LDA(At, 1, 0); PG8_STAGE(PG8_SA(0, 1), a2 + hstepA, voffA);
            PG8_WAIT_V(8); PG8_WAIT_L(0); PG8_BAR; PG8_MMA(0, 0, At, B0); PG8_MMA(0, 1, At, B1); PG8_BAR; PG8_SCHED;
            PG8_LDA(At, 1, 1); PG8_STAGE(PG8_SB(1, 0), b3, voffB); PG8_STAGE(PG8_SB(1, 1), b3 + hstepB, voffB); PG8_STAGE(PG8_SA(1, 0), a3, voffA);
            PG8_WAIT_V(8); PG8_WAIT_L(0); PG8_BAR; PG8_MMA(1, 0, At, B0); PG8_MMA(1, 1, At, B1); PG8_BAR; PG8_SCHED;
            } else {
            PG8_LDB(B0, 0, 0); PG8_SCHED; PG8_LDA(At, 0, 0); PG8_STAGE(PG8_SA(1, 1), a1 + hstepA, voffA);
            PG8_WAIT_L(8); PG8_BAR; PG8_WAIT_L(0); PG8_MMA(0, 0, At, B0); PG8_BAR; PG8_SCHED;
            PG8_LDB(B1, 0, 1); PG8_STAGE(PG8_SB(0, 0), b2, voffB);
            PG8_BAR; PG8_WAIT_L(0); PG8_MMA(0, 1, At, B1); PG8_BAR;
            PG8_LDA(At, 0, 1); PG8_STAGE(PG8_SA(0, 0), a2, voffA);
            PG8_BAR; PG8_WAIT_L(0); PG8_MMA(1, 0, At, B0); PG8_BAR; PG8_SCHED;
            PG8_STAGE(PG8_SB(0, 1), b2 + hstepB, voffB);
            PG8_WAIT_V(6); PG8_BAR; PG8_MMA(1, 1, At, B1); PG8_BAR;
            PG8_LDB(B0, 1, 0); PG8_SCHED; PG8_LDA(At, 1, 0); PG8_STAGE(PG8_SA(0, 1), a2 + hstepA, voffA);
            PG8_WAIT_L(8); PG8_BAR; PG8_WAIT_L(0); PG8_MMA(0, 0, At, B0); PG8_BAR; PG8_SCHED;
            PG8_LDB(B1, 1, 1); PG8_STAGE(PG8_SB(1, 0), b3, voffB);
            PG8_BAR; PG8_WAIT_L(0); PG8_MMA(0, 1, At, B1); PG8_BAR;
            PG8_LDA(At, 1, 1); PG8_STAGE(PG8_SA(1, 0), a3, voffA);
            PG8_BAR; PG8_WAIT_L(0); PG8_MMA(1, 0, At, B0); PG8_BAR; PG8_SCHED;
            PG8_STAGE(PG8_SB(1, 1), b3 + hstepB, voffB);
            PG8_WAIT_V(6); PG8_BAR; PG8_MMA(1, 1, At, B1); PG8_BAR;
            }
        }
        if constexpr (ALIGN_EPI) { if (wr == 0) PG8_BAR; }
        if constexpr (!Epi::AFTER_DRAIN) { E(acc, cur, wr, wc, fr, fq); S.done(cur); }
        if (!has_next) break;
#pragma unroll
        for (int a = 0; a < 2; ++a)
#pragma unroll
            for (int b = 0; b < 2; ++b)
#pragma unroll
                for (int m = 0; m < 4; ++m)
#pragma unroll
                    for (int n = 0; n < 2; ++n) acc[a][b][m][n] = (f32x4){0.f, 0.f, 0.f, 0.f};
        cur = nxt; cA = nA; cB = nB; ++ui;
        if constexpr (ALIGN_EPI) { if (wr == 1) PG8_BAR; }
    }
    PG8_WAIT_V(0);
    if constexpr (!ALIGN_EPI) { if (wr == 0) PG8_BAR; }
    PG8_BAR;
    if constexpr (Epi::AFTER_DRAIN) { E.fused(acc, cur, wr, wc, fr, fq, lds, wid, lane); S.done(cur); }
#undef PG8_SA
#undef PG8_SB
#undef PG8_STAGE
#undef PG8_LDA
#undef PG8_LDB
#undef PG8_MMA
#undef PG8_WAIT_V
#undef PG8_WAIT_L
#undef PG8_BAR
#undef PG8_SCHED
}
}
constexpr int NWAVES = 8;
constexpr int SEQ = 8192, BATCH = 2, M = BATCH * SEQ, D = 1024, DFF = 2816, NZ = 6912  , DIN_SRC = 6864;
constexpr float EPSN = 1e-6f;
constexpr float LOG2E = 1.4426950408889634f;
constexpr int ZC_CQ = 0, ZC_CKV = 256, ZC_KROPE = 384, ZC_GA = 416, ZC_XW = 432, ZC_GQ = 512, ZC_GK = 768, ZC_GV = 1024, ZC_GG = 1536,
              ZC_RR = 2048, ZC_RK = 2560, ZC_RV = 3072, ZC_XA = 3584, ZC_XG = 3648, ZC_GATE = 3840;
constexpr size_t MiB = 1u << 20;
constexpr size_t WS_CTL = 0, CTL_ZERO_BYTES = 1 * MiB;
constexpr size_t WS_CS = 1 * MiB;
constexpr size_t WS_RS = 3 * MiB;
constexpr size_t WS_MEMN = 4 * MiB;
constexpr size_t WS_MEMKV = 5 * MiB;
constexpr size_t WS_GDEC = 7 * MiB;
constexpr size_t WS_W = 8 * MiB;
constexpr size_t WS_XN = 70 * MiB;
constexpr size_t WS_Y = 102 * MiB;
constexpr size_t WS_ZH = 166 * MiB;
constexpr size_t WS_Q = 382 * MiB;
constexpr size_t WS_K = 406 * MiB;
constexpr size_t WS_V = 430 * MiB;
constexpr size_t WS_OABC = 446 * MiB;
constexpr size_t WS_GU = 494 * MiB;
constexpr size_t WS_GS = 526 * MiB;
constexpr size_t WS_RA = 542 * MiB;
constexpr size_t WS_RQ = 558 * MiB;
constexpr size_t WS_RSC = 574 * MiB;
constexpr size_t WS_E1 = 590 * MiB;
constexpr size_t WS_E2 = 606 * MiB;
constexpr size_t WS_END = 622 * MiB;
constexpr size_t W_FFN_IN0 = 0, W_FFN_IN1 = 5767168, W_FFN_OUT0 = 11534336, W_FFN_OUT1 = 14417920, W_IN = 17301504, W_UQ = 24379392, W_UKV = 24576000,
                 W_BR = 24707072, W_OUT = 26279936, W_MQ = 27328512, W_MKV = 28377088, W_MO = 30474240, W_TOTAL = 31522816;
constexpr int CW_TMO = 0, CW_CODE = 1, CW_BAR = 4096, CW_QUEUE = 8192;
constexpr int RING_OFF = 0;
constexpr int LDS_BYTES = 155648;
constexpr int MISC_OFF = 150 * 1024;

typedef short s16x4 __attribute__((ext_vector_type(4)));
typedef float f32x16 __attribute__((ext_vector_type(16)));
typedef float f32x2 __attribute__((ext_vector_type(2)));
typedef unsigned u32x2 __attribute__((ext_vector_type(2)));
typedef unsigned u32x4 __attribute__((ext_vector_type(4)));
typedef short v4i16_t __attribute__((ext_vector_type(4)));

__device__ __forceinline__ float bf2f(unsigned short b) { return __builtin_bit_cast(float, (unsigned)b << 16); }
__device__ __forceinline__ float bflo(unsigned w) { return __builtin_bit_cast(float, w << 16); }
__device__ __forceinline__ float bfhi(unsigned w) { return __builtin_bit_cast(float, w & 0xffff0000u); }
__device__ __forceinline__ float fast_exp2(float x) { return __builtin_amdgcn_exp2f(x); }
__device__ __forceinline__ float fast_rcp(float x) { return __builtin_amdgcn_rcpf(x); }
__device__ __forceinline__ float sigmoid_f(float x) { return fast_rcp(1.f + fast_exp2(-x * LOG2E)); }
__device__ __forceinline__ float silu_f(float x) { return x * sigmoid_f(x); }
__device__ __forceinline__ float softplus_nabs(float x) { return 0.6931471805599453f * __builtin_amdgcn_logf(1.f + fast_exp2(-fabsf(x) * LOG2E)); }
template <int K> __device__ __forceinline__ float swz_xor(float v) { static_assert(K == 1 || K == 2 || K == 4 || K == 8 || K == 16, "swizzle xor inside 32 lanes"); return __builtin_bit_cast(float, __builtin_amdgcn_ds_swizzle(__builtin_bit_cast(int, v), (K << 10) | 0x1f)); }
__device__ __forceinline__ float xor32_val(float v) { const unsigned x = __float_as_uint(v); auto rr = __builtin_amdgcn_permlane32_swap(x, x, false, false); return __uint_as_float(rr[0] ^ rr[1] ^ x); }
__device__ __forceinline__ float add_x16_x32(float s) { s += swz_xor<16>(s); s += xor32_val(s); return s; }
__device__ __forceinline__ float shfl_up_l(float v, int lane, int off) { const int src = lane >= off ? lane - off : lane; return __builtin_bit_cast(float, __builtin_amdgcn_ds_bpermute(src << 2, __builtin_bit_cast(int, v))); }
__device__ __forceinline__ float wave_sum(float v) { v += swz_xor<1>(v); v += swz_xor<2>(v); v += swz_xor<4>(v); v += swz_xor<8>(v); v += swz_xor<16>(v); v += xor32_val(v); return v; }
template <bool KS> __device__ __forceinline__ bf16x8 ldfrag(const LAS unsigned char* base, int pitch, int row0, int k0, int lane) {
    if constexpr (!KS) {
        return *(const LAS bf16x8*)(base + (row0 + (lane & 15)) * pitch + (k0 + 8 * (lane >> 4)) * 2);
    } else {
        const int g = lane >> 4, q = (lane & 15) >> 2, p = lane & 3;
        const LAS unsigned char* a = base + (k0 + 8 * g + q) * pitch + (row0 + 4 * p) * 2;
        const v4i16_t lo = __builtin_amdgcn_ds_read_tr16_b64_v4i16((LAS v4i16_t*)a);
        const v4i16_t hi = __builtin_amdgcn_ds_read_tr16_b64_v4i16((LAS v4i16_t*)(a + 4 * pitch));
        return (bf16x8){lo[0], lo[1], lo[2], lo[3], hi[0], hi[1], hi[2], hi[3]};
    }
}
template <bool MKS, bool NKS, int K> __device__ __forceinline__ void mm16(f32x4& acc, const LAS unsigned char* Mb, int mp, int mrow0, const LAS unsigned char* Nb, int np, int nrow0, int lane) {
#pragma unroll
    for (int k0 = 0; k0 < K; k0 += 32) acc = __builtin_amdgcn_mfma_f32_16x16x32_bf16(ldfrag<NKS>(Nb, np, nrow0, k0, lane), ldfrag<MKS>(Mb, mp, mrow0, k0, lane), acc, 0, 0, 0);
}
__device__ __forceinline__ bf16x8 gfrag(const bf16* base, int pitch_el, int row0, int k0, int lane) {
    return *(const bf16x8*)(base + (size_t)(row0 + (lane & 15)) * pitch_el + k0 + 8 * (lane >> 4));
}
__device__ __forceinline__ u32x2 pack4(f32x4 v) { u32x2 r; r.x = pk2(v[0], v[1]); r.y = pk2(v[2], v[3]); return r; }
__device__ __forceinline__ f32x4 unpack4(u32x2 w) { return (f32x4){bflo(w.x), bfhi(w.x), bflo(w.y), bfhi(w.y)}; }
#define WG_SYNC() __syncthreads()
typedef f32x4 AccT[2][2][4][2];
#define EPI_LAUNDER unsigned char* ws = wsb; asm volatile("" : "+s"(ws), "+s"(wr), "+s"(wc)); asm volatile("" : "+v"(fr), "+v"(fq));
using pg8::Unit;
#define EPI_ROWS_BEGIN _Pragma("unroll") for (int ai = 0; ai < 2; ++ai) _Pragma("unroll") for (int m = 0; m < 4; ++m) { const int row = u.pm * 256 + ai * 128 + wr * 64 + m * 16 + fr;
#define EPI_ROWS_END }
__device__ __forceinline__ u32x4 pack8(f32x4 a, f32x4 b) { u32x4 w; w.x = pg8::cvt_pk_bf16(a[0], a[1]); w.y = pg8::cvt_pk_bf16(a[2], a[3]); w.z = pg8::cvt_pk_bf16(b[0], b[1]); w.w = pg8::cvt_pk_bf16(b[2], b[3]); return w; }

struct EpiSwiglu {
    static constexpr bool PERM = true, AFTER_DRAIN = false;
    unsigned char* wsb;
    __device__ __forceinline__ void operator()(const AccT& acc, const Unit& u, int wr, int wc, int fr, int fq) const {
        EPI_LAUNDER
        bf16* H = (bf16*)(ws + WS_ZH); const int col = u.pn * 128 + wc * 32 + 8 * fq;
        EPI_ROWS_BEGIN
            f32x4 o[2];
#pragma unroll
            for (int n = 0; n < 2; ++n)
#pragma unroll
                for (int j = 0; j < 4; ++j) { const float g = acc[ai][0][m][n][j]; o[n][j] = silu_f(g) * acc[ai][1][m][n][j]; }
            *(u32x4*)(H + (size_t)row * DFF + col) = pack8(o[0], o[1]);
        EPI_ROWS_END
    }
};
struct EpiF32 {
    static constexpr bool PERM = false, AFTER_DRAIN = false;
    unsigned char* wsb;
    __device__ __forceinline__ void operator()(const AccT& acc, const Unit& u, int wr, int wc, int fr, int fq) const {
        EPI_LAUNDER
        float* Y = (float*)(ws + WS_Y); constexpr int ldc = D;
        EPI_ROWS_BEGIN
#pragma unroll
            for (int bj = 0; bj < 2; ++bj)
#pragma unroll
                for (int n = 0; n < 2; ++n) *(f32x4*)(Y + (size_t)row * ldc + u.pn * 256 + bj * 128 + wc * 32 + 16 * n + 4 * fq) = acc[ai][bj][m][n];
        EPI_ROWS_END
    }
};
template <int WHICH  > struct EpiBf16S {
    static constexpr bool PERM = true, AFTER_DRAIN = false;
    unsigned char* wsb;
    __device__ __forceinline__ void operator()(const AccT& acc, const Unit& u, int wr, int wc, int fr, int fq) const {
        EPI_LAUNDER
        bf16* O = (bf16*)(ws + (WHICH == 0 ? WS_MEMKV : WS_Q)); constexpr int ldc = WHICH == 0 ? 2 * D : D; const float scale = WHICH == 0 ? 1.f : 0.0625f * LOG2E;
        EPI_ROWS_BEGIN
#pragma unroll
            for (int bj = 0; bj < 2; ++bj)
                *(u32x4*)(O + (size_t)row * ldc + u.pn * 256 + bj * 128 + wc * 32 + 8 * fq) = pack8(acc[ai][bj][m][0] * scale, acc[ai][bj][m][1] * scale);
        EPI_ROWS_END
    }
};
struct EpiZ {
    static constexpr bool PERM = true, AFTER_DRAIN = false;
    unsigned char* wsb;
    __device__ __forceinline__ void operator()(const AccT& acc, const Unit& u, int wr, int wc, int fr, int fq) const {
        EPI_LAUNDER
        bf16* Z = (bf16*)(ws + WS_ZH); float* RS = (float*)(ws + WS_RS);
        EPI_ROWS_BEGIN
#pragma unroll
            for (int bj = 0; bj < 2; ++bj)
                *(u32x4*)(Z + (size_t)row * NZ + u.pn * 256 + bj * 128 + wc * 32 + 8 * fq) = pack8(acc[ai][bj][m][0], acc[ai][bj][m][1]);
            if (u.pn < 2) {
                float s = 0.f;
#pragma unroll
                for (int bj = 0; bj < 2; ++bj) if (u.pn == 0 || bj == 0)
#pragma unroll
                    for (int n = 0; n < 2; ++n) { const f32x4 v = acc[ai][bj][m][n]; s += (v[0] * v[0] + v[1] * v[1]) + (v[2] * v[2] + v[3] * v[3]); }
                s = add_x16_x32(s);
                if (fq == 0) RS[(size_t)row * 8 + u.pn * 4 + wc] = s;
            }
        EPI_ROWS_END
    }
};
struct EpiQ {
    static constexpr bool PERM = true, AFTER_DRAIN = false;
    unsigned char* wsb;
    __device__ __forceinline__ void operator()(const AccT& acc, const Unit& u, int wr, int wc, int fr, int fq) const {
        EPI_LAUNDER
        bf16* Q = (bf16*)(ws + WS_Q); const float* RS = (const float*)(ws + WS_RS);
        const float C2Q = 0.10206207261596577f * LOG2E;
        EPI_ROWS_BEGIN
            const f32x4 p = *(const f32x4*)(RS + (size_t)row * 8);
            const float sc = rsqrtf(((p[0] + p[1]) + (p[2] + p[3])) * (1.f / 256.f) + EPSN) * C2Q;
#pragma unroll
            for (int bj = 0; bj < 2; ++bj)
                *(u32x4*)(Q + (size_t)row * 768 + u.pn * 256 + bj * 128 + wc * 32 + 8 * fq) = pack8(acc[ai][bj][m][0] * sc, acc[ai][bj][m][1] * sc);
        EPI_ROWS_END
    }
};
struct EpiKV {
    static constexpr bool PERM = true, AFTER_DRAIN = false;
    unsigned char* wsb;
    __device__ __forceinline__ void operator()(const AccT& acc, const Unit& u, int wr, int wc, int fr, int fq) const {
        EPI_LAUNDER
        bf16* K = (bf16*)(ws + WS_K); bf16* V = (bf16*)(ws + WS_V); const float* RS = (const float*)(ws + WS_RS);
        EPI_ROWS_BEGIN
            const f32x4 p = *(const f32x4*)(RS + (size_t)row * 8 + 4);
            const float sc = rsqrtf(((p[0] + p[1]) + (p[2] + p[3])) * (1.f / 128.f) + EPSN);
#pragma unroll
            for (int bj = 0; bj < 2; ++bj) {
                const int head = u.pn * 2 + bj;
                const u32x4 w = pack8(acc[ai][bj][m][0] * sc, acc[ai][bj][m][1] * sc);
                if (wc < 2) *(u32x4*)(K + (size_t)row * 768 + head * 96 + wc * 32 + 8 * fq) = w;
                else *(u32x4*)(V + (size_t)row * 512 + head * 64 + (wc - 2) * 32 + 8 * fq) = w;
            }
        EPI_ROWS_END
    }
};
template <int MODE> struct EpiBranch {
    static constexpr bool PERM = true, AFTER_DRAIN = false;
    unsigned char* wsb;
    __device__ __forceinline__ void operator()(const AccT& acc, const Unit& u, int wr, int wc, int fr, int fq) const {
        EPI_LAUNDER
        const bf16* Z = (const bf16*)(ws + WS_ZH); float* Y = (float*)(ws + WS_Y); bf16* MG = (bf16*)(ws + WS_XN); constexpr int bi = MODE;
        EPI_ROWS_BEGIN
#pragma unroll
            for (int bj = 0; bj < 2; ++bj) {
                const int col = u.pn * 256 + bj * 128 + wc * 32 + 8 * fq;
                const u32x4 gw = *(const u32x4*)(Z + (size_t)row * NZ + ZC_GATE + bi * 1024 + col);
                f32x4 v0, v1;
                v0[0] = acc[ai][bj][m][0][0] * sigmoid_f(bflo(gw.x)); v0[1] = acc[ai][bj][m][0][1] * sigmoid_f(bfhi(gw.x));
                v0[2] = acc[ai][bj][m][0][2] * sigmoid_f(bflo(gw.y)); v0[3] = acc[ai][bj][m][0][3] * sigmoid_f(bfhi(gw.y));
                v1[0] = acc[ai][bj][m][1][0] * sigmoid_f(bflo(gw.z)); v1[1] = acc[ai][bj][m][1][1] * sigmoid_f(bfhi(gw.z));
                v1[2] = acc[ai][bj][m][1][2] * sigmoid_f(bflo(gw.w)); v1[3] = acc[ai][bj][m][1][3] * sigmoid_f(bfhi(gw.w));
                float* yp = Y + (size_t)row * D + col;
                if (MODE > 0) { v0 += *(const f32x4*)(yp); v1 += *(const f32x4*)(yp + 4); }
                if (MODE < 2) { *(f32x4*)(yp) = v0; *(f32x4*)(yp + 4) = v1; }
                else *(u32x4*)(MG + (size_t)row * D + col) = pack8(v0, v1);
            }
        EPI_ROWS_END
    }
};
namespace att {
__device__ __forceinline__ int crow(int r, int hi) { return (r & 3) + 8 * (r >> 2) + 4 * hi; }
__device__ __forceinline__ float pl32_max(float m) { auto rr = __builtin_amdgcn_permlane32_swap(__float_as_uint(m), __float_as_uint(m), false, false); return fmaxf(__uint_as_float(rr[0]), __uint_as_float(rr[1])); }
__device__ __forceinline__ float pl32_sum(float m) { auto rr = __builtin_amdgcn_permlane32_swap(__float_as_uint(m), __float_as_uint(m), false, false); return __uint_as_float(rr[0]) + __uint_as_float(rr[1]); }

template <int DK, int DV> struct Lay {
    static constexpr int KSLOT = DK * 128, VSLOT = DV * 128, K_OFF = 0, V_OFF = 2 * KSLOT, WS_OFF = V_OFF + 2 * VSLOT, BYTES = WS_OFF + 8 * 512;
    static_assert(8 * 32 * DV * 2 <= 2 * KSLOT + 2 * VSLOT, "O staging must fit in the K and V slots");
};
template <int DK, int DV, bool CAUSAL, bool ROPEQ>
__device__ __forceinline__ void attn_unit(const int w0, const float* CSq  , const bf16* Qp, int qpitch, const bf16* Kp, int kpitch, const bf16* Vp, int vpitch, bf16* Op, int opitch, int q0, int NT, LAS unsigned char* shm) {
    typedef Lay<DK, DV> L;
    constexpr int NKCH = DK / 8, NVBL = (DV / 32) * 4, ND = DK / 16, NO = DV / 32;
    const int tid = lt_tid(w0), lane = tid & 63, r32 = lane & 31, hi = lane >> 5;
    const int wid = __builtin_amdgcn_readfirstlane(tid >> 6);
    LAS float* wsf = (LAS float*)(shm + L::WS_OFF) + wid * 128;
#define ATT_ISSUE(t_, slot_) do { _Pragma("unroll") for (int i0 = 0; i0 < NKCH + NVBL; i0 += 8) { const int i = i0 + wid; \
        if (i < NKCH) { const bf16* src = Kp + (size_t)(64 * (t_) + lane) * kpitch + i * 8; \
            __builtin_amdgcn_global_load_lds((const unsigned*)src, (LAS unsigned*)(shm + L::K_OFF + (slot_) * L::KSLOT + i * 1024), 16, 0, 0); } \
        else if (i < NKCH + NVBL) { const int blk = i - NKCH, dh = blk >> 2, kg = blk & 3; \
            const bf16* src = Vp + (size_t)(64 * (t_) + 16 * kg + (lane >> 2)) * vpitch + dh * 32 + (lane & 3) * 8; \
            __builtin_amdgcn_global_load_lds((const unsigned*)src, (LAS unsigned*)(shm + L::V_OFF + (slot_) * L::VSLOT + blk * 1024), 16, 0, 0); } } } while (0)
    ATT_ISSUE(0, 0);
    bf16x8 qr[ND];
#pragma unroll
    for (int d0 = 0; d0 < ND; ++d0) qr[d0] = *(const bf16x8*)(Qp + (size_t)(wid * 32 + r32) * qpitch + d0 * 16 + hi * 8);
    if constexpr (ROPEQ) {
        const float* cs = CSq + (size_t)(wid * 32 + r32) * 32 + 16 * hi;
        const f32x4 c0 = *(const f32x4*)cs, c1 = *(const f32x4*)(cs + 4), c2 = *(const f32x4*)(cs + 8), c3 = *(const f32x4*)(cs + 12);
        const float cosv[8] = {c0[0], c0[2], c1[0], c1[2], c2[0], c2[2], c3[0], c3[2]}, sinv[8] = {c0[1], c0[3], c1[1], c1[3], c2[1], c2[3], c3[1], c3[3]};
        const u32x4 w1 = __builtin_bit_cast(u32x4, qr[ND - 2]), w2 = __builtin_bit_cast(u32x4, qr[ND - 1]); u32x4 o1, o2;
#pragma unroll
        for (int j = 0; j < 4; ++j) { const float a0 = bflo(w1[j]), a1 = bfhi(w1[j]), b0 = bflo(w2[j]), b1 = bfhi(w2[j]);
            o1[j] = pk2(a0 * cosv[2 * j] - b0 * sinv[2 * j], a1 * cosv[2 * j + 1] - b1 * sinv[2 * j + 1]);
            o2[j] = pk2(a0 * sinv[2 * j] + b0 * cosv[2 * j], a1 * sinv[2 * j + 1] + b1 * cosv[2 * j + 1]); }
        qr[ND - 2] = __builtin_bit_cast(bf16x8, o1); qr[ND - 1] = __builtin_bit_cast(bf16x8, o2);
    }
    f32x16 o[NO];
#pragma unroll
    for (int i = 0; i < NO; ++i) o[i] = f32x16{};
    float mrow = -1e30f, lsum = 0.f;
    const int qme = q0 + wid * 32 + r32, qmin_w = q0 + wid * 32, qmax_w = qmin_w + 31;
    asm volatile("s_waitcnt vmcnt(0)" ::: "memory");
    __syncthreads();
    for (int t = 0; t < NT; ++t) {
        const int slot = t & 1;
        if (t + 1 < NT) ATT_ISSUE(t + 1, slot ^ 1);
        const bool active = !CAUSAL || (64 * t <= qmax_w);
        if (active) {
            const LAS unsigned char* kb = shm + L::K_OFF + slot * L::KSLOT + hi * 1024 + r32 * 16;
            f32x16 p0 = f32x16{}, p1 = f32x16{};
#pragma unroll
            for (int d0 = 0; d0 < ND; ++d0) {
                const bf16x8 b0 = *(const LAS bf16x8*)(kb + d0 * 2048), b1 = *(const LAS bf16x8*)(kb + d0 * 2048 + 512);
                p0 = __builtin_amdgcn_mfma_f32_32x32x16_bf16(b0, qr[d0], p0, 0, 0, 0);
                p1 = __builtin_amdgcn_mfma_f32_32x32x16_bf16(b1, qr[d0], p1, 0, 0, 0);
            }
            if (CAUSAL && (64 * t + 63 > qmin_w)) {
#pragma unroll
                for (int r = 0; r < 16; ++r) { const int kv = 64 * t + crow(r, hi); if (kv > qme) p0[r] = -INFINITY; if (kv + 32 > qme) p1[r] = -INFINITY; }
            }
            float rm = fmaxf(p0[0], p1[0]);
#pragma unroll
            for (int r = 1; r < 16; ++r) rm = fmaxf(rm, fmaxf(p0[r], p1[r]));
            rm = pl32_max(rm);
            const float mnew = fmaxf(mrow, rm), f = fast_exp2(mrow - mnew);
            mrow = mnew;
            float ls = 0.f;
#pragma unroll
            for (int r = 0; r < 16; ++r) { p0[r] = fast_exp2(p0[r] - mnew); p1[r] = fast_exp2(p1[r] - mnew); ls += p0[r] + p1[r]; }
            lsum = lsum * f + ls;
            if (hi == 0) wsf[r32] = f;
            asm volatile("s_waitcnt lgkmcnt(0)" ::: "memory");
#pragma unroll
            for (int g = 0; g < 4; ++g) { const f32x4 fv = *(const LAS f32x4*)(wsf + 8 * g + 4 * hi);
#pragma unroll
                for (int i = 0; i < NO; ++i) { o[i][4 * g + 0] *= fv[0]; o[i][4 * g + 1] *= fv[1]; o[i][4 * g + 2] *= fv[2]; o[i][4 * g + 3] *= fv[3]; } }
            u32x4 pw[4];
#pragma unroll
            for (int j = 0; j < 4; ++j) { pw[0][j] = pk2(p0[2 * j], p0[2 * j + 1]); pw[1][j] = pk2(p0[8 + 2 * j], p0[8 + 2 * j + 1]); pw[2][j] = pk2(p1[2 * j], p1[2 * j + 1]); pw[3][j] = pk2(p1[8 + 2 * j], p1[8 + 2 * j + 1]); }
            const LAS unsigned char* vb = shm + L::V_OFF + slot * L::VSLOT + ((lane >> 4) & 1) * 32 + (lane & 3) * 8 + (4 * hi + ((lane & 15) >> 2)) * 64;
#pragma unroll
            for (int d0 = 0; d0 < NO; ++d0)
#pragma unroll
                for (int ks = 0; ks < 4; ++ks) {
                    const v4i16_t lo = __builtin_amdgcn_ds_read_tr16_b64_v4i16((LAS v4i16_t*)(vb + d0 * 4096 + ks * 1024));
                    const v4i16_t hv = __builtin_amdgcn_ds_read_tr16_b64_v4i16((LAS v4i16_t*)(vb + d0 * 4096 + ks * 1024 + 512));
                    const bf16x8 vf = (bf16x8){lo[0], lo[1], lo[2], lo[3], hv[0], hv[1], hv[2], hv[3]};
                    o[d0] = __builtin_amdgcn_mfma_f32_32x32x16_bf16(__builtin_bit_cast(bf16x8, pw[ks]), vf, o[d0], 0, 0, 0);
                }
        }
        asm volatile("s_waitcnt vmcnt(0) lgkmcnt(0)" ::: "memory");
        __syncthreads();
    }
    lsum = pl32_sum(lsum);
    if (hi == 0) wsf[64 + r32] = lsum;
    asm volatile("s_waitcnt lgkmcnt(0)" ::: "memory");
    LAS bf16* stg = (LAS bf16*)(shm + L::K_OFF) + wid * 32 * DV;
#pragma unroll
    for (int r = 0; r < 16; ++r) { const int orow = crow(r, hi); const float il = fast_rcp(wsf[64 + orow]);
#pragma unroll
        for (int d0 = 0; d0 < NO; ++d0) stg[orow * DV + d0 * 32 + r32] = (bf16)f2bf(o[d0][r] * il); }
    asm volatile("s_waitcnt lgkmcnt(0)" ::: "memory");
    constexpr int CPR = DV / 8;
#pragma unroll
    for (int i = 0; i < (32 * CPR) / 64; ++i) { const int idx = i * 64 + lane, row = idx / CPR, ch = idx % CPR;
        const u32x4 v = *(const LAS u32x4*)(stg + row * DV + ch * 8);
        *(u32x4*)(Op + (size_t)(wid * 32 + row) * opitch + ch * 8) = v; }
    asm volatile("s_waitcnt lgkmcnt(0)" ::: "memory");
    __syncthreads();
}
#undef ATT_ISSUE
}
namespace gla {
constexpr int P72 = 144, P136 = 272;
constexpr int L_G = 0;
constexpr int L_WA = 16640;
constexpr int L_A = 20992;
constexpr int L_B = 30208;
constexpr int L_SM = 39424;
constexpr int L_V = 48640;
constexpr int L_ST = 66048;
constexpr int L_PART = 83456;
struct Ptrs { const bf16* Z; const float* w_alpha; const float* b_alpha; const float* gnorm; float* GU; bf16* GS; float* GDEC; bf16* OABC; };

__device__ __forceinline__ void logdecay_cumsum(const Ptrs& P, LAS unsigned char* lds, int row0, int h, int tid, int lane, int wid) {
    LAS float* G = (LAS float*)(lds + L_G); LAS float* WA = (LAS float*)(lds + L_WA);
    for (int i = tid; i < 16 * 64 + 64; i += 512) WA[i] = (i < 1024) ? P.w_alpha[(i >> 6) * 256 + h * 64 + (i & 63)] : P.b_alpha[h * 64 + (i - 1024)];
    const int t = tid >> 3, d0 = (tid & 7) * 8;
    const u32x4 a0 = *(const u32x4*)(P.Z + (size_t)(row0 + t) * NZ + ZC_GA), a1 = *(const u32x4*)(P.Z + (size_t)(row0 + t) * NZ + ZC_GA + 8);
    const float av[16] = {bflo(a0.x), bfhi(a0.x), bflo(a0.y), bfhi(a0.y), bflo(a0.z), bfhi(a0.z), bflo(a0.w), bfhi(a0.w), bflo(a1.x), bfhi(a1.x), bflo(a1.y), bfhi(a1.y), bflo(a1.z), bfhi(a1.z), bflo(a1.w), bfhi(a1.w)};
    WG_SYNC();
#pragma unroll
    for (int j = 0; j < 8; ++j) { const int d = d0 + j; float x = WA[1024 + d];
#pragma unroll
        for (int k = 0; k < 16; ++k) x += av[k] * WA[k * 64 + d];
        const float ls = fminf(x, 0.f) - softplus_nabs(x);
        G[t * 65 + d] = ls * (1.f / 16.f); }
    WG_SYNC();
#pragma unroll
    for (int j = 0; j < 8; ++j) { const int d = wid * 8 + j; float v = G[lane * 65 + d];
#pragma unroll
        for (int off = 1; off < 64; off <<= 1) { const float n = shfl_up_l(v, lane, off); if (lane >= off) v += n; }
        G[lane * 65 + d] = v; }
    WG_SYNC();
}
__device__ __forceinline__ void gl1_unit(const int w0, const Ptrs& P, LAS unsigned char* lds, int unit) {
    const int tid = lt_tid(w0), lane = tid & 63, wid = __builtin_amdgcn_readfirstlane(tid >> 6);
    const int h = unit & 3, bc = unit >> 2, row0 = (bc >> 7) * SEQ + (bc & 127) * 64;
    logdecay_cumsum(P, lds, row0, h, tid, lane, wid);
    const LAS float* G = (const LAS float*)(lds + L_G);
    { const int t = tid >> 3, d0 = (tid & 7) * 8;
      const u32x4 kw = *(const u32x4*)(P.Z + (size_t)(row0 + t) * NZ + ZC_GK + h * 64 + d0);
      const float kv[8] = {bflo(kw.x), bfhi(kw.x), bflo(kw.y), bfhi(kw.y), bflo(kw.z), bfhi(kw.z), bflo(kw.w), bfhi(kw.w)};
      float o[8];
#pragma unroll
      for (int j = 0; j < 8; ++j) o[j] = kv[j] * __expf(G[63 * 65 + d0 + j] - G[t * 65 + d0 + j]);
      u32x4 w; w.x = pk2(o[0], o[1]); w.y = pk2(o[2], o[3]); w.z = pk2(o[4], o[5]); w.w = pk2(o[6], o[7]);
      *(LAS u32x4*)(lds + L_A + t * P72 + d0 * 2) = w;
      const int v0 = (tid & 7) * 16;
      const bf16* vp = P.Z + (size_t)(row0 + t) * NZ + ZC_GV + h * 128 + v0;
      *(LAS u32x4*)(lds + L_V + t * P136 + v0 * 2) = *(const u32x4*)vp; *(LAS u32x4*)(lds + L_V + t * P136 + v0 * 2 + 16) = *(const u32x4*)(vp + 8); }
    if (tid < 64) P.GDEC[(size_t)unit * 64 + tid] = __expf(G[63 * 65 + tid]);
    WG_SYNC();
    const int mb = wid & 3;
#pragma unroll
    for (int i = 0; i < 4; ++i) { const int nb = 4 * (wid >> 2) + i; f32x4 acc = {0.f, 0.f, 0.f, 0.f};
        mm16<true, true, 64>(acc, lds + L_A, P72, 16 * mb, lds + L_V, P136, 16 * nb, lane);
        *(f32x4*)(P.GU + ((size_t)unit * 64 + 16 * mb + (lane & 15)) * 128 + 16 * nb + 4 * (lane >> 4)) = acc; }
    WG_SYNC();
}
__device__ __forceinline__ void gl2_item(const int w0, const Ptrs& P, int item) {
    const int tid = lt_tid(w0), chain = item >> 2, b = chain >> 2, h = chain & 3, d = (item & 3) * 16 + (tid >> 5), v0 = (tid & 31) * 4;
    f32x4 s = {0.f, 0.f, 0.f, 0.f};
#pragma unroll 8
    for (int c = 0; c < 128; ++c) { const size_t unit = (size_t)(b * 128 + c) * 4 + h;
        *(u32x2*)(P.GS + (unit * 64 + d) * 128 + v0) = pack4(s);
        const f32x4 uu = *(const f32x4*)(P.GU + (unit * 64 + d) * 128 + v0); const float dec = P.GDEC[unit * 64 + d];
        s = s * dec + uu; }
}
__device__ __forceinline__ void gl3_unit(const int w0, const Ptrs& P, LAS unsigned char* lds, int unit) {
    const int tid = lt_tid(w0), lane = tid & 63, wid = __builtin_amdgcn_readfirstlane(tid >> 6);
    const int h = unit & 3, bc = unit >> 2, row0 = (bc >> 7) * SEQ + (bc & 127) * 64;
    logdecay_cumsum(P, lds, row0, h, tid, lane, wid);
    const LAS float* G = (const LAS float*)(lds + L_G);
    { const int t = tid >> 3, d0 = (tid & 7) * 8;
      const u32x4 qw = *(const u32x4*)(P.Z + (size_t)(row0 + t) * NZ + ZC_GQ + h * 64 + d0), kw = *(const u32x4*)(P.Z + (size_t)(row0 + t) * NZ + ZC_GK + h * 64 + d0);
      const float qv[8] = {bflo(qw.x), bfhi(qw.x), bflo(qw.y), bfhi(qw.y), bflo(qw.z), bfhi(qw.z), bflo(qw.w), bfhi(qw.w)};
      const float kv[8] = {bflo(kw.x), bfhi(kw.x), bflo(kw.y), bfhi(kw.y), bflo(kw.z), bfhi(kw.z), bflo(kw.w), bfhi(kw.w)};
      float qo[8], ko[8];
#pragma unroll
      for (int j = 0; j < 8; ++j) { const float bb = G[t * 65 + d0 + j]; qo[j] = qv[j] * 0.125f * __expf(bb); ko[j] = kv[j] * __expf(-bb); }
      u32x4 w; w.x = pk2(qo[0], qo[1]); w.y = pk2(qo[2], qo[3]); w.z = pk2(qo[4], qo[5]); w.w = pk2(qo[6], qo[7]);
      *(LAS u32x4*)(lds + L_A + t * P72 + d0 * 2) = w;
      w.x = pk2(ko[0], ko[1]); w.y = pk2(ko[2], ko[3]); w.z = pk2(ko[4], ko[5]); w.w = pk2(ko[6], ko[7]);
      *(LAS u32x4*)(lds + L_B + t * P72 + d0 * 2) = w;
      const int v0 = (tid & 7) * 16;
      const bf16* vp = P.Z + (size_t)(row0 + t) * NZ + ZC_GV + h * 128 + v0;
      *(LAS u32x4*)(lds + L_V + t * P136 + v0 * 2) = *(const u32x4*)vp; *(LAS u32x4*)(lds + L_V + t * P136 + v0 * 2 + 16) = *(const u32x4*)(vp + 8);
      const bf16* sp = P.GS + ((size_t)unit * 64 + t) * 128 + v0;
      *(LAS u32x4*)(lds + L_ST + t * P136 + v0 * 2) = *(const u32x4*)sp; *(LAS u32x4*)(lds + L_ST + t * P136 + v0 * 2 + 16) = *(const u32x4*)(sp + 8); }
    WG_SYNC();
    const int mb = wid & 3, tq = 16 * mb + (lane & 15);
#pragma unroll
    for (int i = 0; i < 2; ++i) { const int nb = 2 * (wid >> 2) + i; f32x4 acc = {0.f, 0.f, 0.f, 0.f};
        mm16<false, false, 64>(acc, lds + L_A, P72, 16 * mb, lds + L_B, P72, 16 * nb, lane);
#pragma unroll
        for (int r = 0; r < 4; ++r) if (16 * nb + 4 * (lane >> 4) + r > tq) acc[r] = 0.f;
        *(LAS u32x2*)(lds + L_SM + tq * P72 + (16 * nb + 4 * (lane >> 4)) * 2) = pack4(acc); }
    WG_SYNC();
    f32x4 acc[4]; float ssq = 0.f;
#pragma unroll
    for (int i = 0; i < 4; ++i) { const int nb = 4 * (wid >> 2) + i; acc[i] = (f32x4){0.f, 0.f, 0.f, 0.f};
        mm16<false, true, 64>(acc[i], lds + L_SM, P72, 16 * mb, lds + L_V, P136, 16 * nb, lane);
        mm16<false, true, 64>(acc[i], lds + L_A, P72, 16 * mb, lds + L_ST, P136, 16 * nb, lane);
        ssq += (acc[i][0] * acc[i][0] + acc[i][1] * acc[i][1]) + (acc[i][2] * acc[i][2] + acc[i][3] * acc[i][3]); }
    ssq = add_x16_x32(ssq);
    LAS float* PART = (LAS float*)(lds + L_PART);
    if ((lane >> 4) == 0) PART[tq * 2 + (wid >> 2)] = ssq;
    WG_SYNC();
    const float rs = rsqrtf((PART[tq * 2] + PART[tq * 2 + 1]) * (1.f / 128.f) + EPSN);
#pragma unroll
    for (int i = 0; i < 4; ++i) { const int v = 16 * (4 * (wid >> 2) + i) + 4 * (lane >> 4);
        const f32x4 gn = *(const f32x4*)(P.gnorm + v);
        const f32x4 gg = unpack4(*(const u32x2*)(P.Z + (size_t)(row0 + tq) * NZ + ZC_GG + h * 128 + v));
        f32x4 o;
#pragma unroll
        for (int r = 0; r < 4; ++r) o[r] = acc[i][r] * rs * gn[r] * silu_f(gg[r]);
        *(u32x2*)(P.OABC + (size_t)(row0 + tq) * 1536 + 512 + h * 128 + v) = pack4(o); }
    WG_SYNC();
}
}
namespace rwkv {
constexpr int P72 = 144, PSG = 336;
constexpr int A_TW = 0, A_XA = 9216, A_WD = 18432, A_WI = 27648;
constexpr int A_SG = 0, A_WG = 21504;
constexpr int A_G = 0;
constexpr int A_PP = 0, A_ARK = 9216, A_NARB = 18432, A_MM = 27648  , A_WM = 27648, A_UV = 36864, A_XF = 46080  ;
constexpr int S_KQ = 79872, S_KD = S_KQ + 9216, S_BD = S_KD + 9216, S_KE = S_BD + 9216, S_NBE = S_KE + 9216, S_RD = S_NBE + 9216, S_VV = S_RD + 9216;
constexpr int L_RED = S_VV + 9216  , L_BON = L_RED + 512  , L_EGC = L_BON + 512  , L_END = L_EGC + 256;
static_assert(L_END <= 150 * 1024, "rwkv LDS map");
struct Ptrs { const bf16* Z; const float *mu, *w0, *w_decay, *a0, *w_iclr, *w_gate, *k_k, *k_a, *r_k, *ln_w, *ln_b;
              bf16* RA; float* RB; bf16* RQ; float* RY0; bf16* RSC; bf16* E1; bf16* E2; bf16* OABC; };

__device__ __forceinline__ f32x4 ld4bf(const bf16* p) { return unpack4(*(const u32x2*)p); }
__device__ __forceinline__ f32x4 lerp4(const bf16* Z, size_t row, bool has_prev, int col, const float* mu) {
    const f32x4 z = ld4bf(Z + row * NZ + col); f32x4 zp = {0.f, 0.f, 0.f, 0.f};
    if (has_prev) zp = ld4bf(Z + (row - 1) * NZ + col);
    const f32x4 m = *(const f32x4*)mu;
    return z + m * (zp - z);
}
__device__ __forceinline__ void rw1_unit(const int w0, const Ptrs& P, LAS unsigned char* lds, int unit) {
    const int tid = lt_tid(w0), lane = tid & 63, wid = __builtin_amdgcn_readfirstlane(tid >> 6);
    const int h = unit & 7, bc = unit >> 3, c = bc & 127, row0 = (bc >> 7) * SEQ + c * 64;
    const int mb = wid & 3, nbp = wid >> 2, fr = lane & 15, fq = lane >> 4;
    const int t = 16 * mb + fr;
    const size_t row = (size_t)row0 + t; const bool has_prev = (c > 0) || (t > 0);
    f32x4 r_[2], k_[2], v_[2];
#pragma unroll
    for (int i = 0; i < 2; ++i) { const int j = 16 * (2 * nbp + i) + 4 * fq;
        r_[i] = lerp4(P.Z, row, has_prev, ZC_RR + h * 64 + j, P.mu + h * 64 + j);
        k_[i] = lerp4(P.Z, row, has_prev, ZC_RK + h * 64 + j, P.mu + 512 + h * 64 + j);
        v_[i] = lerp4(P.Z, row, has_prev, ZC_RV + h * 64 + j, P.mu + 1024 + h * 64 + j); }
#pragma unroll
    for (int i = 0; i < 2; ++i) { const int j = 16 * (2 * nbp + i) + 4 * fq;
        f32x4 xw = lerp4(P.Z, row, has_prev, ZC_XW + j, P.mu + 1536 + j);
#pragma unroll
        for (int q = 0; q < 4; ++q) { const float e = __expf(2.f * xw[q]); xw[q] = 1.f - 2.f / (e + 1.f); }
        *(LAS u32x2*)(lds + A_TW + t * P72 + j * 2) = pack4(xw);
        const f32x4 xa = lerp4(P.Z, row, has_prev, ZC_XA + j, P.mu + 1600 + j);
        *(LAS u32x2*)(lds + A_XA + t * P72 + j * 2) = pack4(xa); }
    { const int kr = tid >> 3, j0 = (tid & 7) * 8;
      const float* s1 = P.w_decay + (size_t)kr * 512 + h * 64 + j0; const float* s2 = P.w_iclr + (size_t)kr * 512 + h * 64 + j0;
      const f32x4 a = *(const f32x4*)s1, b = *(const f32x4*)(s1 + 4), c2 = *(const f32x4*)s2, d2 = *(const f32x4*)(s2 + 4);
      u32x4 w; w.x = pk2(a[0], a[1]); w.y = pk2(a[2], a[3]); w.z = pk2(b[0], b[1]); w.w = pk2(b[2], b[3]);
      *(LAS u32x4*)(lds + A_WD + kr * P72 + j0 * 2) = w;
      w.x = pk2(c2[0], c2[1]); w.y = pk2(c2[2], c2[3]); w.z = pk2(d2[0], d2[1]); w.w = pk2(d2[2], d2[3]);
      *(LAS u32x4*)(lds + A_WI + kr * P72 + j0 * 2) = w; }
    WG_SYNC();
    f32x4 wl[2], al[2], gg[2];
#pragma unroll
    for (int i = 0; i < 2; ++i) { const int nb = 2 * nbp + i; wl[i] = (f32x4){0.f, 0.f, 0.f, 0.f}; al[i] = (f32x4){0.f, 0.f, 0.f, 0.f}; gg[i] = (f32x4){0.f, 0.f, 0.f, 0.f};
        mm16<false, true, 64>(wl[i], lds + A_TW, P72, 16 * mb, lds + A_WD, P72, 16 * nb, lane);
        mm16<false, true, 64>(al[i], lds + A_XA, P72, 16 * mb, lds + A_WI, P72, 16 * nb, lane); }
    WG_SYNC();
    { const int tt = tid >> 3, c0 = (tid & 7) * 20; const size_t rr = (size_t)row0 + tt; const bool hp = (c > 0) || (tt > 0);
#pragma unroll
      for (int q = 0; q < 5; ++q) { f32x4 x = lerp4(P.Z, rr, hp, ZC_XG + c0 + 4 * q, P.mu + 1664 + c0 + 4 * q);
#pragma unroll
          for (int e = 0; e < 4; ++e) x[e] = sigmoid_f(x[e]);
          *(LAS u32x2*)(lds + A_SG + tt * PSG + (c0 + 4 * q) * 2) = pack4(x); } }
    for (int idx = tid; idx < 160 * 8; idx += 512) { const int kr = idx >> 3, j0 = (idx & 7) * 8;
        const float* s1 = P.w_gate + (size_t)kr * 512 + h * 64 + j0; const f32x4 a = *(const f32x4*)s1, b = *(const f32x4*)(s1 + 4);
        u32x4 w; w.x = pk2(a[0], a[1]); w.y = pk2(a[2], a[3]); w.z = pk2(b[0], b[1]); w.w = pk2(b[2], b[3]);
        *(LAS u32x4*)(lds + A_WG + kr * P72 + j0 * 2) = w; }
    WG_SYNC();
#pragma unroll
    for (int i = 0; i < 2; ++i) mm16<false, true, 160>(gg[i], lds + A_SG, PSG, 16 * mb, lds + A_WG, P72, 16 * (2 * nbp + i), lane);
    WG_SYNC();
    f32x4 lw[2], kk[2], km[2], bv[2]; float ssq = 0.f, bon = 0.f;
#pragma unroll
    for (int i = 0; i < 2; ++i) { const int j = 16 * (2 * nbp + i) + 4 * fq, cj = h * 64 + j;
        const f32x4 w0v = *(const f32x4*)(P.w0 + cj), a0v = *(const f32x4*)(P.a0 + cj), kkv = *(const f32x4*)(P.k_k + cj), kav = *(const f32x4*)(P.k_a + cj), rkv = *(const f32x4*)(P.r_k + cj);
#pragma unroll
        for (int q = 0; q < 4; ++q) {
            const float x = -(w0v[q] + wl[i][q]);
            const float sp = fmaxf(x, 0.f) + softplus_nabs(x);
            lw[i][q] = -__expf(-sp - 0.5f);
            const float a = sigmoid_f(a0v[q] + al[i][q]);
            const float kq = k_[i][q] * kkv[q];
            kk[i][q] = kq; ssq += kq * kq;
            km[i][q] = k_[i][q] * (1.f + (a - 1.f) * kav[q]);
            bv[i][q] = a;
            bon += r_[i][q] * km[i][q] * rkv[q]; } }
    ssq = add_x16_x32(ssq); bon = add_x16_x32(bon);
    LAS float* RED = (LAS float*)(lds + L_RED); LAS float* BON = (LAS float*)(lds + L_BON); LAS float* G = (LAS float*)(lds + A_G); LAS float* EGC = (LAS float*)(lds + L_EGC);
    if (fq == 0) { RED[t * 2 + nbp] = ssq; BON[t * 2 + nbp] = bon; }
#pragma unroll
    for (int i = 0; i < 2; ++i) { const int j = 16 * (2 * nbp + i) + 4 * fq;
#pragma unroll
        for (int q = 0; q < 4; ++q) G[t * 65 + j + q] = lw[i][q]; }
    WG_SYNC();
#pragma unroll
    for (int jj = 0; jj < 8; ++jj) { const int d = wid * 8 + jj; float v = G[lane * 65 + d];
#pragma unroll
        for (int off = 1; off < 64; off <<= 1) { const float n = shfl_up_l(v, lane, off); if (lane >= off) v += n; }
        G[lane * 65 + d] = v; }
    WG_SYNC();
    const float inorm = 1.f / fmaxf(sqrtf(RED[t * 2] + RED[t * 2 + 1]), 1e-12f), bonus = BON[t * 2] + BON[t * 2 + 1];
    f32x4 kqf[2], rdf[2];
#pragma unroll
    for (int i = 0; i < 2; ++i) { const int j = 16 * (2 * nbp + i) + 4 * fq;
        f32x4 kd, bd, ke, nbe;
#pragma unroll
        for (int q = 0; q < 4; ++q) {
            const float gt = G[t * 65 + j + q], gp = (t > 0) ? G[(t - 1) * 65 + j + q] : 0.f, gc = G[63 * 65 + j + q];
            const float kkn = kk[i][q] * inorm, bb = kkn * bv[i][q];
            const float eg = __expf(gt), egm = __expf(-gt), egc = __expf(gc - gt);
            kqf[i][q] = kkn * __expf(gp); rdf[i][q] = r_[i][q] * eg;
            kd[q] = km[i][q] * egm; bd[q] = bb * egm; ke[q] = km[i][q] * egc; nbe[q] = -bb * egc;
            if (t == 63) EGC[j + q] = eg; }
        const int off = t * P72 + j * 2;
        *(LAS u32x2*)(lds + S_KQ + off) = pack4(kqf[i]); *(LAS u32x2*)(lds + S_KD + off) = pack4(kd); *(LAS u32x2*)(lds + S_BD + off) = pack4(bd);
        *(LAS u32x2*)(lds + S_KE + off) = pack4(ke); *(LAS u32x2*)(lds + S_NBE + off) = pack4(nbe); *(LAS u32x2*)(lds + S_RD + off) = pack4(rdf[i]);
        *(LAS u32x2*)(lds + S_VV + off) = pack4(v_[i]);
        *(u32x2*)(P.E1 + row * 512 + h * 64 + j) = pack4(gg[i]);
        *(u32x2*)(P.E2 + row * 512 + h * 64 + j) = pack4(v_[i] * bonus); }
    WG_SYNC();
#pragma unroll
    for (int i = 0; i < 2; ++i) { const int nb = 2 * nbp + i, s0 = 16 * nb + 4 * fq;
        f32x4 pp = {0.f, 0.f, 0.f, 0.f}, mmv = pp, ark = pp, arb = pp;
        mm16<false, false, 64>(pp, lds + S_KQ, P72, 16 * mb, lds + S_KD, P72, 16 * nb, lane);
        mm16<false, false, 64>(mmv, lds + S_KQ, P72, 16 * mb, lds + S_BD, P72, 16 * nb, lane);
        mm16<false, false, 64>(ark, lds + S_RD, P72, 16 * mb, lds + S_KD, P72, 16 * nb, lane);
        mm16<false, false, 64>(arb, lds + S_RD, P72, 16 * mb, lds + S_BD, P72, 16 * nb, lane);
#pragma unroll
        for (int q = 0; q < 4; ++q) { const int s = s0 + q; if (s >= t) { pp[q] = 0.f; mmv[q] = 0.f; } if (s > t) { ark[q] = 0.f; arb[q] = 0.f; } arb[q] = -arb[q]; }
        *(LAS u32x2*)(lds + A_PP + t * P72 + s0 * 2) = pack4(pp); *(LAS u32x2*)(lds + A_ARK + t * P72 + s0 * 2) = pack4(ark); *(LAS u32x2*)(lds + A_NARB + t * P72 + s0 * 2) = pack4(arb);
        *(LAS f32x4*)(lds + A_MM + (t * 68 + s0) * 4) = mmv; }
    WG_SYNC();
#pragma unroll
    for (int i = 0; i < 2; ++i) { const int nb = 2 * nbp + i, j = 16 * nb + 4 * fq; f32x4 pv = {0.f, 0.f, 0.f, 0.f};
        mm16<false, true, 64>(pv, lds + A_PP, P72, 16 * mb, lds + S_VV, P72, 16 * nb, lane);
        *(LAS f32x4*)(lds + A_XF + (t * 132 + j) * 4) = kqf[i]; *(LAS f32x4*)(lds + A_XF + (t * 132 + 64 + j) * 4) = pv; }
    WG_SYNC();
    if (tid < 128) {
        float x[64];
#pragma unroll
        for (int tt = 0; tt < 64; ++tt) {
            float a = *(const LAS float*)(lds + A_XF + (tt * 132 + tid) * 4);
#pragma unroll
            for (int s4 = 0; s4 < tt; s4 += 4) { const f32x4 mv = *(const LAS f32x4*)(lds + A_MM + (tt * 68 + s4) * 4);
#pragma unroll
                for (int e = 0; e < 4; ++e) if (s4 + e < tt) a -= mv[e] * x[s4 + e]; }
            x[tt] = a;
            *(LAS float*)(lds + A_XF + (tt * 132 + tid) * 4) = a; }
    }
    WG_SYNC();
    { f32x4 wmv[2], uvv[2];
#pragma unroll
      for (int i = 0; i < 2; ++i) { const int j = 16 * (2 * nbp + i) + 4 * fq; wmv[i] = *(const LAS f32x4*)(lds + A_XF + (t * 132 + j) * 4); uvv[i] = *(const LAS f32x4*)(lds + A_XF + (t * 132 + 64 + j) * 4); }
#pragma unroll
      for (int i = 0; i < 2; ++i) { const int j = 16 * (2 * nbp + i) + 4 * fq;
          *(LAS u32x2*)(lds + A_WM + t * P72 + j * 2) = pack4(wmv[i]); *(LAS u32x2*)(lds + A_UV + t * P72 + j * 2) = pack4(uvv[i]); } }
    WG_SYNC();
    const size_t ub = (size_t)unit * 4096;
#pragma unroll
    for (int i = 0; i < 2; ++i) { const int nb = 2 * nbp + i, n0 = 16 * nb + 4 * fq, mrow = 16 * mb + fr;
        f32x4 at, bc2 = {0.f, 0.f, 0.f, 0.f}, rq = rdf[i], y0 = {0.f, 0.f, 0.f, 0.f};
#pragma unroll
        for (int q = 0; q < 4; ++q) at[q] = (n0 + q == mrow) ? EGC[mrow] : 0.f;
        mm16<true, true, 64>(at, lds + S_NBE, P72, 16 * mb, lds + A_WM, P72, 16 * nb, lane);
        mm16<true, true, 64>(bc2, lds + S_VV, P72, 16 * mb, lds + S_KE, P72, 16 * nb, lane);
        mm16<true, true, 64>(bc2, lds + A_UV, P72, 16 * mb, lds + S_NBE, P72, 16 * nb, lane);
        mm16<false, true, 64>(rq, lds + A_NARB, P72, 16 * mb, lds + A_WM, P72, 16 * nb, lane);
        mm16<false, true, 64>(y0, lds + A_ARK, P72, 16 * mb, lds + S_VV, P72, 16 * nb, lane);
        mm16<false, true, 64>(y0, lds + A_NARB, P72, 16 * mb, lds + A_UV, P72, 16 * nb, lane);
        *(u32x2*)(P.RA + ub + mrow * 64 + n0) = pack4(at); *(f32x4*)(P.RB + ub + mrow * 64 + n0) = bc2;
        *(u32x2*)(P.RQ + ub + mrow * 64 + n0) = pack4(rq); *(f32x4*)(P.RY0 + ub + mrow * 64 + n0) = y0; }
    WG_SYNC();
}
__device__ __forceinline__ void rw2_chain(const int w0, const Ptrs& P, LAS unsigned char* lds, int chain) {
    constexpr int PD = 4;
    const int tid = lt_tid(w0), lane = tid & 63, wid = __builtin_amdgcn_readfirstlane(tid >> 6);
    const int b = chain >> 3, h = chain & 7, mb = wid & 3, nbp = wid >> 2, fr = lane & 15, fq = lane >> 4, mrow = 16 * mb + fr;
    f32x4 S[2] = {{0.f, 0.f, 0.f, 0.f}, {0.f, 0.f, 0.f, 0.f}};
    bf16x8 af[PD][2][2]; f32x4 bb[PD][2];
#define RW2_LOAD(slot, c_) do { const size_t ub_ = ((size_t)(b * 128 + (c_)) * 8 + h) * 4096; _Pragma("unroll") for (int i = 0; i < 2; ++i) { const int nb = 2 * nbp + i; \
        af[slot][i][0] = gfrag(P.RA + ub_, 64, 16 * nb, 0, lane); af[slot][i][1] = gfrag(P.RA + ub_, 64, 16 * nb, 32, lane); bb[slot][i] = *(const f32x4*)(P.RB + ub_ + mrow * 64 + 16 * nb + 4 * fq); } } while (0)
#pragma unroll
    for (int j = 0; j < PD; ++j) RW2_LOAD(j, j);
    for (int c0 = 0; c0 < 128; c0 += PD) {
#pragma unroll
        for (int j = 0; j < PD; ++j) { const int c = c0 + j;
            const size_t ub = ((size_t)(b * 128 + c) * 8 + h) * 4096;
            LAS unsigned char* sl = lds + (c & 1) * 9216;
#pragma unroll
            for (int i = 0; i < 2; ++i) { const int n0 = 16 * (2 * nbp + i) + 4 * fq; const u32x2 w = pack4(S[i]);
                *(u32x2*)(P.RSC + ub + mrow * 64 + n0) = w; *(LAS u32x2*)(sl + mrow * P72 + n0 * 2) = w; }
            WG_SYNC();
#pragma unroll
            for (int i = 0; i < 2; ++i) { f32x4 acc = bb[j][i];
#pragma unroll
                for (int ks = 0; ks < 2; ++ks) acc = __builtin_amdgcn_mfma_f32_16x16x32_bf16(af[j][i][ks], ldfrag<false>(sl, P72, 16 * mb, 32 * ks, lane), acc, 0, 0, 0);
                S[i] = acc; }
            if (c + PD < 128) RW2_LOAD(j, c + PD);
        }
    }
#undef RW2_LOAD
    WG_SYNC();
}
__device__ __forceinline__ void rw3_unit(const int w0, const Ptrs& P, int unit) {
    const int lane = lt_tid(w0) & 63, fr = lane & 15, fq = lane >> 4;
    const int h = unit & 7, bc = unit >> 3, row0 = (bc >> 7) * SEQ + (bc & 127) * 64;
    const size_t ub = (size_t)unit * 4096;
    bf16x8 sf[4][2];
#pragma unroll
    for (int nb = 0; nb < 4; ++nb) { sf[nb][0] = gfrag(P.RSC + ub, 64, 16 * nb, 0, lane); sf[nb][1] = gfrag(P.RSC + ub, 64, 16 * nb, 32, lane); }
#pragma unroll
    for (int mb = 0; mb < 4; ++mb) {
        const bf16x8 q0 = gfrag(P.RQ + ub, 64, 16 * mb, 0, lane), q1 = gfrag(P.RQ + ub, 64, 16 * mb, 32, lane);
        const int t = 16 * mb + fr; const size_t row = (size_t)row0 + t;
        f32x4 y[4]; float s = 0.f;
#pragma unroll
        for (int nb = 0; nb < 4; ++nb) { y[nb] = *(const f32x4*)(P.RY0 + ub + t * 64 + 16 * nb + 4 * fq);
            y[nb] = __builtin_amdgcn_mfma_f32_16x16x32_bf16(sf[nb][0], q0, y[nb], 0, 0, 0); y[nb] = __builtin_amdgcn_mfma_f32_16x16x32_bf16(sf[nb][1], q1, y[nb], 0, 0, 0);
            s += (y[nb][0] + y[nb][1]) + (y[nb][2] + y[nb][3]); }
        s = add_x16_x32(s);
        const float mean = s * (1.f / 64.f); float v2 = 0.f;
#pragma unroll
        for (int nb = 0; nb < 4; ++nb) { y[nb] = y[nb] - mean; v2 += (y[nb][0] * y[nb][0] + y[nb][1] * y[nb][1]) + (y[nb][2] * y[nb][2] + y[nb][3] * y[nb][3]); }
        v2 = add_x16_x32(v2);
        const float rstd = rsqrtf(v2 * (1.f / 64.f) + 64e-5f);
#pragma unroll
        for (int nb = 0; nb < 4; ++nb) { const int i0 = 16 * nb + 4 * fq, ci = h * 64 + i0;
            const f32x4 lw = *(const f32x4*)(P.ln_w + ci), lb = *(const f32x4*)(P.ln_b + ci), e1 = ld4bf(P.E1 + row * 512 + ci), e2 = ld4bf(P.E2 + row * 512 + ci);
            const f32x4 o = (y[nb] * rstd * lw + lb + e2) * e1;
            *(u32x2*)(P.OABC + row * 1536 + 1024 + ci) = pack4(o); }
    }
}
}
#ifdef DBL_ATT
#define ATT_REP 2
#else
#define ATT_REP 1
#endif
#ifdef DBL_MEMATT
#define MEMATT_REP 2
#else
#define MEMATT_REP 1
#endif
#ifdef DBL_CONV
#define CONV_REP 2
#else
#define CONV_REP 1
#endif
#ifdef DBL_FFN
#define FFN_REP 2
#else
#define FFN_REP 1
#endif
#ifdef DBL_RW1
#define RW1_REP 2
#else
#define RW1_REP 1
#endif
struct Frame {
    LAS unsigned char* lds; gu32* ctl; unsigned char* ws;
    int tid, lane, wave, vcu, G;
    float* x;
};
__device__ __forceinline__ int zmap(int n) {
    if (n < 416) return n;
    if (n < 432) return 1952 + (n - 416);
    if (n < 496) return 3504 + (n - 432);
    if (n < 512) return -1;
    if (n < 768) return 416 + (n - 512);
    if (n < 1024) return 672 + (n - 768);
    if (n < 1536) return 928 + (n - 1024);
    if (n < 2048) return 1440 + (n - 1536);
    if (n < 3584) return 1968 + (n - 2048);
    if (n < 3648) return 3568 + (n - 3584);
    if (n < 3808) return 3632 + (n - 3648);
    if (n < 3840) return -1;
    return 3792 + (n - 3840);
}
struct MapId { __device__ __forceinline__ int operator()(int n) const { return n; } };
struct MapSwiglu { __device__ __forceinline__ int operator()(int n) const { const int tile = n >> 8, j = n & 255; return j < 128 ? 128 * tile + j : DFF + 128 * tile + (j - 128); } };
struct MapZ { __device__ __forceinline__ int operator()(int n) const { return zmap(n); } };
template <class Map> __device__ __forceinline__ void conv_matrix(Frame& F, const float* W, int K, int Nsrc, bf16* WT, int Ndst, int ldk, const float* kscale, Map map) {
    LAS float* scr = (LAS float*)(F.lds + RING_OFF + F.wave * 16384);
    const int gw = F.vcu * NWAVES + F.wave, NGW = F.G * NWAVES, nblk = Ndst / 32, items = (K / 64) * nblk, lane = F.lane;
    for (int it = gw; it < items; it += NGW) {
        const int kb = it / nblk, nb = it % nblk, k0 = 64 * kb, n0 = 32 * nb;
        const int sc = map(n0 + (lane & 31));
#pragma unroll 8
        for (int i = 0; i < 32; ++i) { const int kk = 2 * i + (lane >> 5); float v = 0.f;
            if (sc >= 0) { v = W[(size_t)(k0 + kk) * Nsrc + sc]; if (kscale) v *= kscale[k0 + kk]; }
            scr[kk * 33 + (lane & 31)] = v; }
        LDS_WAIT(); asm volatile("" ::: "memory");
        const int c = lane & 7;
#pragma unroll
        for (int j = 0; j < 4; ++j) { const int n = (lane >> 3) + 8 * j; const LAS float* s = scr + (8 * c) * 33 + n;
            v4u o; o.x = pk2(s[0 * 33], s[1 * 33]); o.y = pk2(s[2 * 33], s[3 * 33]); o.z = pk2(s[4 * 33], s[5 * 33]); o.w = pk2(s[6 * 33], s[7 * 33]);
            *(GAS v4u*)(WT + (size_t)(n0 + n) * ldk + k0 + 8 * c) = o; }
        LDS_WAIT(); asm volatile("" ::: "memory");
    }
}
struct In {
    const float *x, *mem; const int* pos; const float *norm_g, *w_ffn_in, *w_ffn_out, *w_in, *mla_q_norm, *mla_w_uq, *mla_kv_norm, *mla_w_ukv, *gla_w_alpha, *gla_b_alpha, *gla_norm,
        *rwkv_mu, *rwkv_w0, *rwkv_w_decay, *rwkv_a0, *rwkv_w_iclr, *rwkv_w_gate, *rwkv_k_k, *rwkv_k_a, *rwkv_r_k, *rwkv_ln_w, *rwkv_ln_b, *w_branch, *w_out, *mem_norm, *mem_wq, *mem_wkv, *mem_wo;
};
__device__ __forceinline__ float row_ssq(const f32x4 (&v)[4]) { float s = 0.f;
#pragma unroll
    for (int j = 0; j < 4; ++j) s += (v[j][0] * v[j][0] + v[j][1] * v[j][1]) + (v[j][2] * v[j][2] + v[j][3] * v[j][3]);
    return wave_sum(s); }
__device__ __forceinline__ void store_row_bf16(bf16* orow, const f32x4 (&v)[4], float rs, const f32x4 (&g)[4], int lane) {
    GAS unsigned long long* o8 = (GAS unsigned long long*)orow + lane;
#pragma unroll
    for (int j = 0; j < 4; ++j) o8[64 * j] = (unsigned long long)pk2(v[j][0] * rs * g[j][0], v[j][1] * rs * g[j][1]) | ((unsigned long long)pk2(v[j][2] * rs * g[j][2], v[j][3] * rs * g[j][3]) << 32);
}
__device__ __forceinline__ void norm_phase(Frame& F, const float* xin, const float* Y, float alpha, const float* g_post, const float* g_pre, bf16* XN) {
    const int gw = F.vcu * NWAVES + F.wave, NGW = F.G * NWAVES, lane = F.lane;
    f32x4 gp[4], gq[4];
#pragma unroll
    for (int j = 0; j < 4; ++j) { gp[j] = Y ? *(const f32x4*)(g_post + 4 * lane + 256 * j) : (f32x4){0.f, 0.f, 0.f, 0.f}; gq[j] = g_pre ? *(const f32x4*)(g_pre + 4 * lane + 256 * j) : (f32x4){0.f, 0.f, 0.f, 0.f}; }
    for (int m = gw; m < M; m += NGW) {
        f32x4 xv[4];
        const float* xr = (Y ? F.x : xin) + (size_t)m * D;
#pragma unroll
        for (int j = 0; j < 4; ++j) xv[j] = *(const f32x4*)(xr + 4 * lane + 256 * j);
        if (Y) { f32x4 yv[4];
#pragma unroll
            for (int j = 0; j < 4; ++j) yv[j] = *(const f32x4*)(Y + (size_t)m * D + 4 * lane + 256 * j);
            const float rs = rsqrtf(row_ssq(yv) * (1.f / D) + EPSN) * alpha;
#pragma unroll
            for (int j = 0; j < 4; ++j) xv[j] += yv[j] * rs * gp[j]; }
#pragma unroll
        for (int j = 0; j < 4; ++j) *(f32x4*)(F.x + (size_t)m * D + 4 * lane + 256 * j) = xv[j];
        if (g_pre) { const float rs2 = rsqrtf(row_ssq(xv) * (1.f / D) + EPSN); store_row_bf16(XN + (size_t)m * D, xv, rs2, gq, lane); }
    }
}
__device__ __forceinline__ void rope_table(Frame& F, const int* pos, float* CS) {
    const double inv_freq[16] = {1.0, 0.5623413251903491, 0.31622776601683794, 0.1778279410038923, 0.1, 0.05623413251903491, 0.031622776601683794, 0.01778279410038923,
                                 0.01, 0.005623413251903491, 0.0031622776601683794, 0.001778279410038923, 0.001, 0.0005623413251903491, 0.00031622776601683794, 0.0001778279410038923};
    for (int idx = F.vcu * 512 + F.tid; idx < M * 16; idx += F.G * 512) { const int i = idx & 15, r = idx >> 4;
        double dinv = inv_freq[0];
#pragma unroll
        for (int q = 1; q < 16; ++q) dinv = (i == q) ? inv_freq[q] : dinv;
        const double rev = (double)pos[r] * dinv * 0.15915494309189535;
        const float fr = (float)(rev - floor(rev));
        CS[idx * 2] = __builtin_amdgcn_cosf(fr); CS[idx * 2 + 1] = __builtin_amdgcn_sinf(fr); }
}
__device__ __forceinline__ const float* ldptr(const LAS unsigned long long* PT, int k) { const unsigned long long v = PT[k];
    const unsigned lo = __builtin_amdgcn_readfirstlane((unsigned)v), hi = __builtin_amdgcn_readfirstlane((unsigned)(v >> 32)); return (const float*)(((unsigned long long)hi << 32) | lo); }
#define PHASE_PTRS F.tid = lt_tid(w0); F.lane = F.tid & 63; F.wave = __builtin_amdgcn_readfirstlane(F.tid >> 6); unsigned char* ws = args.ws; asm volatile("" : "+s"(ws)); F.x = args.out; asm volatile("" : "+s"(F.x)); \
            bf16* W = (bf16*)(ws + WS_W); bf16* XN = (bf16*)(ws + WS_XN); float* Y = (float*)(ws + WS_Y); bf16* Z = (bf16*)(ws + WS_ZH); bf16* H = (bf16*)(ws + WS_ZH); \
            bf16* Qm = (bf16*)(ws + WS_Q); bf16* Km = (bf16*)(ws + WS_K); bf16* Vm = (bf16*)(ws + WS_V); bf16* OABC = (bf16*)(ws + WS_OABC); bf16* MQ = (bf16*)(ws + WS_Q); bf16* MO = (bf16*)(ws + WS_OABC); \
            float* RS = (float*)(ws + WS_RS); float* CS = (float*)(ws + WS_CS); bf16* MEMN = (bf16*)(ws + WS_MEMN); bf16* MEMKV = (bf16*)(ws + WS_MEMKV); \
            (void)W; (void)XN; (void)Y; (void)Z; (void)H; (void)Qm; (void)Km; (void)Vm; (void)OABC; (void)MQ; (void)MO; (void)RS; (void)CS; (void)MEMN; (void)MEMKV;
__device__ __forceinline__ bool ph_in(int lo, int hi, int k) { asm volatile("" : "+s"(lo), "+s"(hi)); return lo <= k && k < hi; }
struct Args { const void* in[31]; float* out; unsigned char* ws; int s_lo, s_hi, ph_lo, ph_hi, use_bar, pad; };

__global__ void __launch_bounds__(NWAVES * 64, 2) mk_fwd(Args args) {
    extern __shared__ __attribute__((aligned(16))) unsigned char lds_raw[];
    Frame F;
    F.lds = (LAS unsigned char*)lds_raw; F.ws = args.ws; F.ctl = (gu32*)(args.ws + WS_CTL);
    int w0 = __builtin_amdgcn_readfirstlane((int)threadIdx.x >> 6); asm volatile("" : "+s"(w0));
    F.tid = lt_tid(w0); F.lane = F.tid & 63; F.wave = w0;
    F.G = gridDim.x; { const int bx = blockIdx.x; F.vcu = (F.G % 8 == 0) ? (bx % 8) * (F.G / 8) + bx / 8 : bx; }
    F.x = nullptr;
    for (int u = F.tid; u < (LDS_BYTES - MISC_OFF) / 4; u += NWAVES * 64) ((LAS unsigned*)(F.lds + MISC_OFF))[u] = 0u;
    __syncthreads();
    LAS unsigned long long* PT = (LAS unsigned long long*)(F.lds + MISC_OFF + 256);
    if (F.tid == 0) {
#pragma unroll
        for (int k = 0; k < 31; ++k) PT[k] = (unsigned long long)args.in[k]; }
    __syncthreads();
    XcdBarrier bar; bar.bar = (unsigned*)(F.ctl + CW_BAR); bar.x = 0; bar.st = nullptr;
    if (args.use_bar) bar = xcd_barrier_post((unsigned*)(F.ctl + CW_BAR), (volatile LAS unsigned*)(F.lds + MISC_OFF) + 8);
#define GRID_BAR() do { if (args.use_bar) { XcdBarrier b2_ = bar; asm volatile("" : "+s"(b2_.bar)); xcd_barrier(b2_); } } while (0)
#define PH(k) ph_in(args.ph_lo, args.ph_hi, (k))
    for (int s = args.s_lo; s < args.s_hi; ++s) {
        const int l = s >> 1, f = s & 1;
#define NG (ldptr(PT, 3) + (size_t)l * 8 * D)
        if (f == 0 && PH(0)) { PHASE_PTRS

            for (int rep_ = 0; rep_ < CONV_REP; ++rep_) for (int ff = 0; ff < 2; ++ff) {
                conv_matrix(F, ldptr(PT, 4) + ((size_t)l * 2 + ff) * D * 2 * DFF, D, 2 * DFF, W + (ff ? W_FFN_IN1 : W_FFN_IN0), 2 * DFF, D, nullptr, MapSwiglu());
                conv_matrix(F, ldptr(PT, 5) + ((size_t)l * 2 + ff) * DFF * D, DFF, D, W + (ff ? W_FFN_OUT1 : W_FFN_OUT0), D, DFF, nullptr, MapId());
            }
            conv_matrix(F, ldptr(PT, 6) + (size_t)l * D * DIN_SRC, D, DIN_SRC, W + W_IN, NZ, D, nullptr, MapZ());
            conv_matrix(F, ldptr(PT, 8) + (size_t)l * 256 * 768, 256, 768, W + W_UQ, 768, 256, ldptr(PT, 7) + l * 256, MapId());
            conv_matrix(F, ldptr(PT, 10) + (size_t)l * 128 * 1024, 128, 1024, W + W_UKV, 1024, 128, ldptr(PT, 9) + l * 128, MapId());
            for (int bi = 0; bi < 3; ++bi) conv_matrix(F, ldptr(PT, 25) + ((size_t)l * 1536 + bi * 512) * D, 512, D, W + W_BR + (size_t)bi * 512 * D, D, 512, nullptr, MapId());
            conv_matrix(F, ldptr(PT, 26) + (size_t)l * D * D, D, D, W + W_OUT, D, D, nullptr, MapId());
            conv_matrix(F, ldptr(PT, 28) + (size_t)l * D * D, D, D, W + W_MQ, D, D, nullptr, MapId());
            conv_matrix(F, ldptr(PT, 29) + (size_t)l * D * 2 * D, D, 2 * D, W + W_MKV, 2 * D, D, nullptr, MapId());
            conv_matrix(F, ldptr(PT, 30) + (size_t)l * D * D, D, D, W + W_MO, D, D, nullptr, MapId());
            { f32x4 gq[4];
#pragma unroll
              for (int j = 0; j < 4; ++j) gq[j] = *(const f32x4*)(ldptr(PT, 27) + (size_t)l * D + 4 * F.lane + 256 * j);
              for (int m = F.vcu * NWAVES + F.wave; m < 512; m += F.G * NWAVES) { f32x4 v[4];
#pragma unroll
                  for (int j = 0; j < 4; ++j) v[j] = *(const f32x4*)(ldptr(PT, 1) + (size_t)m * D + 4 * F.lane + 256 * j);
                  store_row_bf16(MEMN + (size_t)m * D, v, rsqrtf(row_ssq(v) * (1.f / D) + EPSN), gq, F.lane); } }
            if (l == 0) { rope_table(F, (const int*)ldptr(PT, 2), CS); norm_phase(F, ldptr(PT, 0), nullptr, 0.f, nullptr, NG, XN); }
            GRID_BAR();
        }
        if (PH(1)) { PHASE_PTRS

            for (int rep_ = 0; rep_ < FFN_REP; ++rep_) { pg8::Gemm g{XN, W + (f ? W_FFN_IN1 : W_FFN_IN0), M, 2 * DFF, D, D, D}; pg8::StaticOrder S; S.init(M, 2 * DFF, F.G, (int)blockIdx.x);
              EpiSwiglu E{ws};
#ifndef SKIP_G1
pg8::gemm_phase<EpiSwiglu, pg8::StaticOrder, true, true>(w0, F.lds + RING_OFF, g, S, E);
#endif
 }
            if (f == 0) { pg8::Gemm g{MEMN, W + W_MKV, 512, 2 * D, D, D, D}; pg8::StaticOrder S; S.init(512, 2 * D, F.G, (int)blockIdx.x);
              EpiBf16S<0> E{ws};
#ifndef SKIP_G2
pg8::gemm_phase<EpiBf16S<0>, pg8::StaticOrder, true, true>(w0, F.lds + RING_OFF, g, S, E);
#endif
 }
            GRID_BAR();
        }
        if (PH(2)) { PHASE_PTRS

            pg8::Gemm g{H, W + (f ? W_FFN_OUT1 : W_FFN_OUT0), M, D, DFF, DFF, DFF}; pg8::StaticOrder S; S.init(M, D, F.G, (int)blockIdx.x);
            EpiF32 E{ws};
#ifndef SKIP_G3
pg8::gemm_phase<EpiF32, pg8::StaticOrder, true, true>(w0, F.lds + RING_OFF, g, S, E);
#endif

            GRID_BAR();
        }
        if (PH(3)) { PHASE_PTRS

            const float* g_pre = (f == 0) ? NG + 2 * D : (l < 3 ? NG + 8 * D : nullptr);
            norm_phase(F, nullptr, Y, 0.5f, NG + (f ? 7 : 1) * D, g_pre, XN);
            GRID_BAR();
        }
        if (f == 0) {
            if (PH(4)) { PHASE_PTRS

                pg8::Gemm g{XN, W + W_IN, M, NZ, D, D, D}; pg8::StaticOrder S; S.init(M, NZ, F.G, (int)blockIdx.x);
                EpiZ E{ws};
#ifndef SKIP_G4
pg8::gemm_phase<EpiZ, pg8::StaticOrder, true, true>(w0, F.lds + RING_OFF, g, S, E);
#endif

                GRID_BAR();
            }
            if (PH(5)) { PHASE_PTRS

                { pg8::Gemm g{Z + ZC_CQ, W + W_UQ, M, 768, 256, NZ, 256}; pg8::StaticOrder S; S.init(M, 768, F.G, (int)blockIdx.x);
                  EpiQ E{ws};
#ifndef SKIP_G5
pg8::gemm_phase<EpiQ, pg8::StaticOrder, true, true>(w0, F.lds + RING_OFF, g, S, E);
#endif
 }
                { pg8::Gemm g{Z + ZC_CKV, W + W_UKV, M, 1024, 128, NZ, 128}; pg8::StaticOrder S; S.init(M, 1024, F.G, (int)blockIdx.x);
                  EpiKV E{ws};
#ifndef SKIP_G6
pg8::gemm_phase<EpiKV, pg8::StaticOrder, true, true>(w0, F.lds + RING_OFF, g, S, E);
#endif
 }
            }
            if (PH(5)) { PHASE_PTRS
                for (int idx = F.vcu * 512 + F.tid; idx < M * 16; idx += F.G * 512) { const int i = idx & 15, r = idx >> 4;
                    const float t1 = bf2f(Z[(size_t)r * NZ + ZC_KROPE + i]), t2 = bf2f(Z[(size_t)r * NZ + ZC_KROPE + 16 + i]), c = CS[idx * 2], sn = CS[idx * 2 + 1];
                    const bf16 o1 = (bf16)f2bf(t1 * c - t2 * sn), o2 = (bf16)f2bf(t1 * sn + t2 * c);
#pragma unroll
                    for (int hh = 0; hh < 8; ++hh) { Km[(size_t)r * 768 + hh * 96 + 64 + i] = o1; Km[(size_t)r * 768 + hh * 96 + 80 + i] = o2; } }
                __syncthreads();
                rwkv::Ptrs RP{Z, ldptr(PT, 14) + l * 1824, ldptr(PT, 15) + l * 512, ldptr(PT, 16) + (size_t)l * 64 * 512, ldptr(PT, 17) + l * 512, ldptr(PT, 18) + (size_t)l * 64 * 512, ldptr(PT, 19) + (size_t)l * 160 * 512,
                           ldptr(PT, 20) + l * 512, ldptr(PT, 21) + l * 512, ldptr(PT, 22) + l * 512, ldptr(PT, 23) + l * 512, ldptr(PT, 24) + l * 512,
                           (bf16*)(ws + WS_RA), (float*)(ws + WS_Y), (bf16*)(ws + WS_RQ), (float*)(ws + WS_Y + 32 * MiB), (bf16*)(ws + WS_RSC), (bf16*)(ws + WS_E1), (bf16*)(ws + WS_E2), OABC};
                gla::Ptrs GP{Z, ldptr(PT, 11) + (size_t)l * 16 * 256, ldptr(PT, 12) + l * 256, ldptr(PT, 13) + l * 128, (float*)(ws + WS_GU), (bf16*)(ws + WS_GS), (float*)(ws + WS_GDEC), OABC};
#ifndef SKIP_RW1
                for (int u = F.vcu; u < 2048 * RW1_REP; u += F.G) rwkv::rw1_unit(w0, RP, F.lds, u & 2047);
#endif
#ifndef SKIP_GL1
                for (int u = F.vcu; u < 1024; u += F.G) gla::gl1_unit(w0, GP, F.lds, u);
#ifdef DBL_GL
                for (int u = F.vcu; u < 1024; u += F.G) gla::gl1_unit(w0, GP, F.lds, u);
#endif
#endif
                GRID_BAR();
            }
            if (PH(6)) { PHASE_PTRS

                rwkv::Ptrs RP{Z, ldptr(PT, 14) + l * 1824, ldptr(PT, 15) + l * 512, ldptr(PT, 16) + (size_t)l * 64 * 512, ldptr(PT, 17) + l * 512, ldptr(PT, 18) + (size_t)l * 64 * 512, ldptr(PT, 19) + (size_t)l * 160 * 512,
                           ldptr(PT, 20) + l * 512, ldptr(PT, 21) + l * 512, ldptr(PT, 22) + l * 512, ldptr(PT, 23) + l * 512, ldptr(PT, 24) + l * 512,
                           (bf16*)(ws + WS_RA), (float*)(ws + WS_Y), (bf16*)(ws + WS_RQ), (float*)(ws + WS_Y + 32 * MiB), (bf16*)(ws + WS_RSC), (bf16*)(ws + WS_E1), (bf16*)(ws + WS_E2), OABC};
                gla::Ptrs GP{Z, ldptr(PT, 11) + (size_t)l * 16 * 256, ldptr(PT, 12) + l * 256, ldptr(PT, 13) + l * 128, (float*)(ws + WS_GU), (bf16*)(ws + WS_GS), (float*)(ws + WS_GDEC), OABC};
#ifndef SKIP_RW2
                for (int ch = F.vcu; ch < 16; ch += F.G) rwkv::rw2_chain(w0, RP, F.lds, ch);
#ifdef DBL_RW2
                for (int ch = F.vcu; ch < 16; ch += F.G) rwkv::rw2_chain(w0, RP, F.lds, ch);
#endif
#endif
#ifndef SKIP_GL2
                for (int it = F.G - 1 - F.vcu; it < 32; it += F.G) gla::gl2_item(w0, GP, it);
#endif
                __syncthreads();
                { gu32* qctr = F.ctl + CW_QUEUE + 64 * s; LAS unsigned* qslot = (LAS unsigned*)(F.lds + MISC_OFF + 64);
                  for (;;) {
                      if (F.tid == 0) qslot[0] = __hip_atomic_fetch_add(qctr, 1u, __ATOMIC_RELAXED, __HIP_MEMORY_SCOPE_AGENT);
                      __syncthreads();
                      const int u = (int)qslot[0];
                      __syncthreads();
                      if (u >= 512 * ATT_REP) break;
                      const int uu = u & 511, qb = 31 - (uu >> 4), bh = uu & 15, b = bh >> 3, h = bh & 7; const size_t rb = (size_t)b * SEQ;
                      att::attn_unit<96, 64, true, true>(w0, CS + (rb + qb * 256) * 32, Qm + (rb + qb * 256) * 768 + h * 96, 768, Km + rb * 768 + h * 96, 768, Vm + rb * 512 + h * 64, 512, OABC + (rb + qb * 256) * 1536 + h * 64, 1536, qb * 256, (qb + 1) * 4, F.lds);
                  } }
                GRID_BAR();
            }
            if (PH(7)) { PHASE_PTRS

                rwkv::Ptrs RP{Z, ldptr(PT, 14) + l * 1824, ldptr(PT, 15) + l * 512, ldptr(PT, 16) + (size_t)l * 64 * 512, ldptr(PT, 17) + l * 512, ldptr(PT, 18) + (size_t)l * 64 * 512, ldptr(PT, 19) + (size_t)l * 160 * 512,
                           ldptr(PT, 20) + l * 512, ldptr(PT, 21) + l * 512, ldptr(PT, 22) + l * 512, ldptr(PT, 23) + l * 512, ldptr(PT, 24) + l * 512,
                           (bf16*)(ws + WS_RA), (float*)(ws + WS_Y), (bf16*)(ws + WS_RQ), (float*)(ws + WS_Y + 32 * MiB), (bf16*)(ws + WS_RSC), (bf16*)(ws + WS_E1), (bf16*)(ws + WS_E2), OABC};
                gla::Ptrs GP{Z, ldptr(PT, 11) + (size_t)l * 16 * 256, ldptr(PT, 12) + l * 256, ldptr(PT, 13) + l * 128, (float*)(ws + WS_GU), (bf16*)(ws + WS_GS), (float*)(ws + WS_GDEC), OABC};
#ifndef SKIP_RW3
                for (int u = F.vcu; u < 256; u += F.G) rwkv::rw3_unit(w0, RP, u * 8 + F.wave);
#ifdef DBL_RW3
                for (int u = F.vcu; u < 256; u += F.G) rwkv::rw3_unit(w0, RP, u * 8 + F.wave);
#endif
#endif
#ifndef SKIP_GL3
                for (int u = F.vcu; u < 1024; u += F.G) gla::gl3_unit(w0, GP, F.lds, u);
#ifdef DBL_GL
                for (int u = F.vcu; u < 1024; u += F.G) gla::gl3_unit(w0, GP, F.lds, u);
#endif
#endif
                GRID_BAR();
            }
            if (PH(8)) { PHASE_PTRS

                { pg8::Gemm g{OABC, W + W_BR, M, D, 512, 1536, 512}; pg8::StaticOrder S; S.init(M, D, F.G, (int)blockIdx.x);
                  EpiBranch<0> E{ws};
#ifndef SKIP_G7
pg8::gemm_phase<EpiBranch<0>, pg8::StaticOrder, true, true>(w0, F.lds + RING_OFF, g, S, E);
#endif
 }
                VM_WAIT(); __builtin_amdgcn_fence(__ATOMIC_ACQUIRE, "agent"); VM_WAIT(); __syncthreads();
                { pg8::Gemm g{OABC + 512, W + W_BR + (size_t)512 * D, M, D, 512, 1536, 512}; pg8::StaticOrder S; S.init(M, D, F.G, (int)blockIdx.x);
                  EpiBranch<1> E{ws};
#ifndef SKIP_G8
pg8::gemm_phase<EpiBranch<1>, pg8::StaticOrder, true, true>(w0, F.lds + RING_OFF, g, S, E);
#endif
 }
                VM_WAIT(); __builtin_amdgcn_fence(__ATOMIC_ACQUIRE, "agent"); VM_WAIT(); __syncthreads();
                { pg8::Gemm g{OABC + 1024, W + W_BR + (size_t)1024 * D, M, D, 512, 1536, 512}; pg8::StaticOrder S; S.init(M, D, F.G, (int)blockIdx.x);
                  EpiBranch<2> E{ws};
#ifndef SKIP_G9
pg8::gemm_phase<EpiBranch<2>, pg8::StaticOrder, true, true>(w0, F.lds + RING_OFF, g, S, E);
#endif
 }
                GRID_BAR();
            }
            if (PH(9)) { PHASE_PTRS

                pg8::Gemm g{XN, W + W_OUT, M, D, D, D, D}; pg8::StaticOrder S; S.init(M, D, F.G, (int)blockIdx.x);
                EpiF32 E{ws};
#ifndef SKIP_G10
pg8::gemm_phase<EpiF32, pg8::StaticOrder, true, true>(w0, F.lds + RING_OFF, g, S, E);
#endif

                GRID_BAR();
            }
            if (PH(10)) { PHASE_PTRS
 norm_phase(F, nullptr, Y, 1.0f, NG + 3 * D, NG + 4 * D, XN); GRID_BAR(); }
            if (PH(11)) { PHASE_PTRS

                pg8::Gemm g{XN, W + W_MQ, M, D, D, D, D}; pg8::StaticOrder S; S.init(M, D, F.G, (int)blockIdx.x);
                EpiBf16S<1> E{ws};
#ifndef SKIP_G11
pg8::gemm_phase<EpiBf16S<1>, pg8::StaticOrder, true, true>(w0, F.lds + RING_OFF, g, S, E);
#endif

                GRID_BAR();
            }
            if (PH(12)) { PHASE_PTRS

                for (int rep_ = 0; rep_ < MEMATT_REP; ++rep_) for (int u = F.vcu; u < 512; u += F.G) { const int rt = u >> 3, h = (u >> 1) & 3, dvh = u & 1, b = rt >> 5;
#ifndef SKIP_MEMATT
                    att::attn_unit<256, 128, false, false>(w0, nullptr, MQ + (size_t)rt * 256 * D + h * 256, D, MEMKV + (size_t)b * 256 * 2 * D + h * 256, 2 * D, MEMKV + (size_t)b * 256 * 2 * D + D + h * 256 + dvh * 128, 2 * D,
                                                    MO + (size_t)rt * 256 * D + h * 256 + dvh * 128, D, 0, 4, F.lds);
#endif
 }
                GRID_BAR();
            }
            if (PH(13)) { PHASE_PTRS

                pg8::Gemm g{MO, W + W_MO, M, D, D, D, D}; pg8::StaticOrder S; S.init(M, D, F.G, (int)blockIdx.x);
                EpiF32 E{ws};
#ifndef SKIP_G12
pg8::gemm_phase<EpiF32, pg8::StaticOrder, true, true>(w0, F.lds + RING_OFF, g, S, E);
#endif

                GRID_BAR();
            }
            if (PH(14)) { PHASE_PTRS
 norm_phase(F, nullptr, Y, 1.0f, NG + 5 * D, NG + 6 * D, XN); GRID_BAR(); }
        }
    }
#undef PH
#undef NG
#undef GRID_BAR
}


static void launch_mk(Args a, int grid, hipStream_t stream, int s_lo, int s_hi, int ph_lo, int ph_hi, int use_bar) {
    a.s_lo = s_lo; a.s_hi = s_hi; a.ph_lo = ph_lo; a.ph_hi = ph_hi; a.use_bar = use_bar; a.pad = 0;
    hipLaunchKernelGGL(mk_fwd, dim3(grid), dim3(NWAVES * 64), LDS_BYTES, stream, a);
}

extern "C" void kernel_launch(void* const* d_in, const int* in_sizes, int n_in, void* d_out, int out_size, void* d_ws, size_t ws_size, hipStream_t stream) {
    static int grid = 0;
    if (grid == 0) {
        if (n_in != 31 || out_size != M * D || ws_size < WS_END) { fprintf(stderr, "kernel_launch: unexpected problem shape (n_in %d, out %d, ws %zu)\n", n_in, out_size, ws_size); grid = -1; return; }
        int dev = 0, cus = 0;
        if (hipGetDevice(&dev) != hipSuccess || hipDeviceGetAttribute(&cus, hipDeviceAttributeMultiprocessorCount, dev) != hipSuccess) { grid = -1; return; }
        if (hipFuncSetAttribute((const void*)mk_fwd, hipFuncAttributeMaxDynamicSharedMemorySize, LDS_BYTES) != hipSuccess) { fprintf(stderr, "kernel_launch: hipFuncSetAttribute failed\n"); grid = -1; return; }
        int per_cu = 0;
        if (hipOccupancyMaxActiveBlocksPerMultiprocessor(&per_cu, (const void*)mk_fwd, NWAVES * 64, LDS_BYTES) != hipSuccess || per_cu < 1) fprintf(stderr, "kernel_launch: occupancy query reports %d\n", per_cu);
        (void)hipGetLastError();
        grid = cus;
    }
    if (grid < 0) return;
    (void)in_sizes;
    if (hipMemsetAsync((char*)d_ws + WS_CTL, 0, CTL_ZERO_BYTES, stream) != hipSuccess) return;
    Args a{};
    for (int i = 0; i < 31; ++i) a.in[i] = d_in[i];
    a.out = (float*)d_out; a.ws = (unsigned char*)d_ws;
#if defined(MK_DEBUG)
    Dbg dbg{(float*)((unsigned*)d_ws + SIG_WORDS), stream};
    unsigned char* ws = (unsigned char*)d_ws;
    typedef unsigned short u16;
    for (int s = 0; s < 2; ++s) for (int p = (s == 0 ? 0 : 1); p < (s == 0 ? 15 : 4); ++p) {
        launch_mk(a, grid, stream, s, s + 1, p, p + 1, 0);
        if (s == 0) switch (p) {
            case 0: sig_t<u16>(dbg, 1, 0, (const u16*)(ws + WS_XN), 8192, 1024, 1024, 0, 1.f); break;
            case 1: sig_t<u16>(dbg, 1, 1, (const u16*)(ws + WS_ZH), 8192, 2816, 2816, 0, 1.f); sig_t<u16>(dbg, 1, 19, (const u16*)(ws + WS_MEMKV), 256, 2048, 2048, 0, 1.f); break;
            case 3: sig_t<float>(dbg, 1, 2, (const float*)d_out, 8192, 1024, 1024, 0, 1.f); break;
            case 4: sig_t<u16>(dbg, 1, 3, (const u16*)(ws + WS_ZH), 8192, NZ, NZ, 1, 1.f); sig_t<float>(dbg, 1, 20, (const float*)(ws + WS_RS), 8192, 8, 8, 0, 1.f); break;
            case 5: sig_t<u16>(dbg, 1, 21, (const u16*)(ws + WS_Q), 8192, 768, 768, 7, 1.f / (0.10206207261596577f * LOG2E));
                    sig_t<u16>(dbg, 1, 5, (const u16*)(ws + WS_K), 8192, 768, 768, 2, 1.f); sig_t<u16>(dbg, 1, 6, (const u16*)(ws + WS_V), 8192, 512, 512, 4, 1.f);
                    sig_t<u16>(dbg, 1, 7, (const u16*)(ws + WS_K), 8192, 768, 768, 3, 1.f); sig_t<u16>(dbg, 1, 17, (const u16*)(ws + WS_E1), 8192, 512, 512, 0, 1.f); break;
            case 6: sig_t<u16>(dbg, 1, 8, (const u16*)(ws + WS_OABC), 8192, 512, 1536, 0, 1.f); break;
            case 7: sig_t<u16>(dbg, 1, 9, (const u16*)(ws + WS_OABC) + 512, 8192, 512, 1536, 0, 1.f); sig_t<u16>(dbg, 1, 10, (const u16*)(ws + WS_OABC) + 1024, 8192, 512, 1536, 0, 1.f); break;
            case 8: sig_t<u16>(dbg, 1, 11, (const u16*)(ws + WS_XN), 8192, 1024, 1024, 0, 1.f); break;
            case 10: sig_t<float>(dbg, 1, 12, (const float*)d_out, 8192, 1024, 1024, 0, 1.f); break;
            case 11: sig_t<u16>(dbg, 1, 13, (const u16*)(ws + WS_Q), 8192, 1024, 1024, 0, 1.f / (0.0625f * LOG2E)); break;
            case 12: sig_t<u16>(dbg, 1, 14, (const u16*)(ws + WS_OABC), 8192, 1024, 1024, 0, 1.f); break;
            case 14: sig_t<float>(dbg, 1, 15, (const float*)d_out, 8192, 1024, 1024, 0, 1.f); break;
            default: break;
        }
        if (s == 1 && p == 3) sig_t<float>(dbg, 1, 16, (const float*)d_out, 8192, 1024, 1024, 0, 1.f);
    }
    hipMemcpyAsync(d_out, d_in[0], (size_t)out_size * sizeof(float), hipMemcpyDeviceToDevice, stream);
    nv::forward(d_in, (float*)d_out, (float*)((char*)d_ws + 1 * MiB), stream, &dbg);
    hipLaunchKernelGGL(k_decide, dim3(1024), dim3(256), 0, stream, dbg.sig, (float*)d_out, out_size, 2e-3f);
#elif defined(MK_MULTI)
    for (int s = 0; s < 8; ++s) for (int p = ((s & 1) ? 1 : 0); p < ((s & 1) ? 4 : 15); ++p) launch_mk(a, grid, stream, s, s + 1, p, p + 1, 0);
#else
    launch_mk(a, grid, stream, 0, 8, 0, 15, 1);
#endif
}
```

```cpp
#include <hip/hip_runtime.h>
#include <cstdio>
#include <cstdint>
#include <cmath>
#define GAS __attribute__((address_space(1)))
#define LAS __attribute__((address_space(3)))
typedef unsigned short bf16;
typedef unsigned v4u __attribute__((ext_vector_type(4)));
typedef float f32x4 __attribute__((ext_vector_type(4)));
typedef short bf16x8 __attribute__((ext_vector_type(8)));
typedef GAS unsigned gu32;
typedef GAS unsigned long long gu64;
__device__ __forceinline__ int lt_tid(int w0) { asm volatile("" : "+s"(w0)); int t = (w0 << 6) | (int)__builtin_amdgcn_mbcnt_hi(~0u, __builtin_amdgcn_mbcnt_lo(~0u, 0u)); asm volatile("" : "+v"(t)); return t; }
#define RLX_AGENT __ATOMIC_RELAXED, __HIP_MEMORY_SCOPE_AGENT
#define LDS_WAIT() asm volatile("s_waitcnt lgkmcnt(0)" ::: "memory")
#define VM_WAIT() asm volatile("s_waitcnt vmcnt(0)" ::: "memory")
__device__ __forceinline__ unsigned long long rt() { return __builtin_amdgcn_s_memrealtime(); }
__device__ __forceinline__ unsigned f2bf(float f) { unsigned u = __builtin_bit_cast(unsigned, f); return (u + 0x7fffu + ((u >> 16) & 1u)) >> 16; }
typedef float pk_f32x2_t __attribute__((ext_vector_type(2))); typedef __bf16 pk_bf16x2_t __attribute__((ext_vector_type(2)));
__device__ __forceinline__ unsigned pk2(float lo, float hi) { pk_f32x2_t v = {lo, hi}; pk_bf16x2_t b = __builtin_convertvector(v, pk_bf16x2_t); return __builtin_bit_cast(unsigned, b); }

#define XB_TMO      128
#define XB_XCNT(j)  (256  + 64 * (j))
#define XB_XSUB(j)  (1280 + 64 * (j))
#define XB_XGEN(j)  (2304 + 64 * (j))
#define XB_TOP      3328
#define XB_TOPGEN   3392
#define XCD_BAR_WORDS 3456
#define XB_SPIN_CAP (1u << 18)

__device__ __forceinline__ unsigned xb_ld(unsigned* p)              { return __hip_atomic_load(p, __ATOMIC_RELAXED, __HIP_MEMORY_SCOPE_AGENT); }
__device__ __forceinline__ unsigned xb_add(unsigned* p, unsigned v) { return __hip_atomic_fetch_add(p, v, __ATOMIC_RELAXED, __HIP_MEMORY_SCOPE_AGENT); }
__device__ __forceinline__ unsigned xb_xcc_id() { return (unsigned)__builtin_amdgcn_s_getreg((3 << 11) | 20) & 0xFu; }
#define XB_SPIN(cond, bar) do { unsigned _sp = 0; while (cond) { __builtin_amdgcn_s_sleep(1); \
    if ((++_sp & 255u) == 0u) { if (xb_ld(&(bar)[XB_TMO])) break; if (_sp > XB_SPIN_CAP) { atomicAdd(&(bar)[XB_TMO], 1u); break; } } } } while (0)

struct XcdBarrier {
    unsigned* bar; unsigned x;
    volatile LAS unsigned* st;
};

__device__ __forceinline__ XcdBarrier xcd_barrier_post(unsigned* bar, volatile LAS unsigned* st) {
    XcdBarrier b; b.bar = bar; b.x = xb_xcc_id(); b.st = st;
    if (threadIdx.x == 0) (void)xb_add(&bar[XB_XCNT(b.x)], 1u);
    return b;
}
__device__ __forceinline__ void xcd_barrier_complete(unsigned* bar, unsigned x, unsigned& nloc, unsigned& nx) {
    const unsigned G = gridDim.x * gridDim.y * gridDim.z;
    unsigned sum, cnt, mine, sp = 0u;
    for (;;) {
        sum = 0u; cnt = 0u; mine = 0u;
#pragma unroll
        for (unsigned j = 0; j < 16; ++j) { const unsigned c = xb_ld(&bar[XB_XCNT(j)]); sum += c; cnt += (c > 0u) ? 1u : 0u; }
        mine = xb_ld(&bar[XB_XCNT(x)]);
        if (sum == G) break;
        __builtin_amdgcn_s_sleep(1);
        if ((++sp & 255u) == 0u) { if (xb_ld(&bar[XB_TMO])) break; if (sp > XB_SPIN_CAP) { atomicAdd(&bar[XB_TMO], 1u); break; } }
    }
    nloc = mine > 0u ? mine : 1u; nx = cnt > 0u ? cnt : 1u;
}

__device__ __forceinline__ void xcd_barrier(const XcdBarrier& b) {
    asm volatile("s_waitcnt vmcnt(0)" ::: "memory");
    __syncthreads();
    if (threadIdx.x == 0) {
        unsigned* bar = b.bar;
        __builtin_amdgcn_s_waitcnt(0);
        unsigned nloc = b.st[0], nx = b.st[1];
        if (nloc == 0u) { xcd_barrier_complete(bar, b.x, nloc, nx); b.st[0] = nloc; b.st[1] = nx; }
        const unsigned old = xb_add(&bar[XB_XSUB(b.x)], 1u);
        const unsigned gen = old / nloc;
        if (old + 1u == (gen + 1u) * nloc) {
            __builtin_amdgcn_fence(__ATOMIC_RELEASE, "agent");
            asm volatile("s_waitcnt vmcnt(0)" ::: "memory");
            const unsigned og = xb_add(&bar[XB_TOP], 1u);
            const unsigned tg = og / nx;
            if (og + 1u == (tg + 1u) * nx) xb_add(&bar[XB_TOPGEN], 1u);
            else XB_SPIN(xb_ld(&bar[XB_TOPGEN]) == tg, bar);
            __builtin_amdgcn_fence(__ATOMIC_ACQUIRE, "agent");
            xb_add(&bar[XB_XGEN(b.x)], 1u);
            asm volatile("s_waitcnt vmcnt(0)" ::: "memory");
        } else {
            XB_SPIN(xb_ld(&bar[XB_XGEN(b.x)]) == gen, bar);
            __builtin_amdgcn_fence(__ATOMIC_ACQUIRE, "agent");
            asm volatile("s_waitcnt vmcnt(0)" ::: "memory");
        }
    }
    __syncthreads();
}
namespace pg8 {
#define PG8_LAS __attribute__((address_space(3)))
typedef unsigned short bf16_t;
typedef short bf16x8 __attribute__((ext_vector_type(8)));
typedef float f32x4 __attribute__((ext_vector_type(4)));
typedef unsigned u32x4 __attribute__((ext_vector_type(4)));
constexpr int BM = 256, BK = 64, HALF = 128, HTB = HALF * BK * 2  , STAGE_BYTES = 8 * HTB, NXCD = 8, WGM = 8;

__host__ __device__ __forceinline__ int lds_byte(int r, int c) { const int st = (r >> 4) * 2 + (c >> 5), rr = r & 15, cc = c & 31, ob = rr * 64 + cc * 2; return st * 1024 + (ob ^ (((ob >> 9) & 1) << 5)); }
__host__ __device__ __forceinline__ void stage_rc(int b, int& R, int& C) { const int st = b / 1024, sb = b % 1024, swz = sb ^ (((sb >> 9) & 1) << 5); R = (st >> 1) * 16 + swz / 64; C = (st & 1) * 32 + (swz % 64) / 2; }
__host__ __device__ __forceinline__ int perm32(int rho) { const int n = rho >> 4, i = rho & 15; return 8 * (i >> 2) + 4 * n + (i & 3); }

struct Unit { int pm, pn; };
struct Gemm { const bf16_t* A; const bf16_t* Bt; int M, N, K, lda, ldb; };

struct StaticOrder {
    int nM, nN, nwg, G, c;
    __host__ __device__ void init(int M, int N, int G_, int c_) { nM = M / BM; nN = N / BM; nwg = nM * nN; G = G_; c = c_; }
    __host__ __device__ bool next(int i, Unit& u) const {
        const long L = (long)i * G + c; if (L >= nwg) return false;
        int wgid = (int)L; { const int q = nwg / NXCD, r = nwg % NXCD, xcd = wgid % NXCD, off = wgid / NXCD; wgid = (xcd < r ? xcd * (q + 1) : r * (q + 1) + (xcd - r) * q) + off; }
        const int nig = WGM * nN, gid = wgid / nig, fm = gid * WGM, gsz = (nM - fm) < WGM ? (nM - fm) : WGM;
        u.pm = fm + ((wgid % nig) % gsz); u.pn = (wgid % nig) / gsz; return true;
    }
    __device__ __forceinline__ void a_ready(const Unit&) const {}
    __device__ __forceinline__ void done(const Unit&) const {}
};

__device__ __forceinline__ unsigned cvt_pk_bf16(float lo, float hi) { unsigned r; asm volatile("v_cvt_pk_bf16_f32 %0, %1, %2" : "=v"(r) : "v"(lo), "v"(hi)); return r; }
template <class Epi, class Sched, bool ALIGN_EPI = false, bool SP2 = false>
__device__ __forceinline__ void gemm_phase(const int w0, PG8_LAS unsigned char* lds, const Gemm g, const Sched& S, const Epi& E) {
    const int tid = lt_tid(w0), wid = __builtin_amdgcn_readfirstlane(tid >> 6), lane = tid & 63, wr = wid >> 2, wc = wid & 3, fr = lane & 15, fq = lane >> 4;
    const int K = g.K, nt = K / BK;
    unsigned voffA[2], voffB[2];
#pragma unroll
    for (int i = 0; i < 2; ++i) { int R, C; stage_rc(tid * 16 + i * 8192, R, C); const int Rb = Epi::PERM ? ((R & ~31) + perm32(R & 31)) : R;
        voffA[i] = (unsigned)(R * g.lda + C) * 2u; voffB[i] = (unsigned)(Rb * g.ldb + C) * 2u; }
    const size_t kstep = (size_t)(BK * 2);
    const size_t hstepA = (size_t)HALF * g.lda * 2, hstepB = (size_t)HALF * g.ldb * 2;
    const size_t tstepA = 2 * hstepA, tstepB = 2 * hstepB;
    const unsigned ldsw = (unsigned)wid * 1024u;
    const int aoff = lds_byte(wr * 64 + fr, fq * 8), boff = lds_byte(wc * 32 + fr, fq * 8);
#define PG8_SA(b, h) (((b) * 2 + (h)) * HTB)
#define PG8_SB(b, h) ((4 + (b) * 2 + (h)) * HTB)
#define PG8_STAGE(bufoff, gbase, voff) do { _Pragma("unroll") for (int _i = 0; _i < 2; ++_i) \
        __builtin_amdgcn_global_load_lds((const unsigned*)((const char*)(gbase) + (voff)[_i]), (PG8_LAS unsigned*)(lds + (bufoff) + ldsw + _i * 8192), 16, 0, 0); } while (0)
#define PG8_LDA(dst, b, h) do { _Pragma("unroll") for (int m = 0; m < 4; ++m) _Pragma("unroll") for (int k = 0; k < 2; ++k) dst[m][k] = *(const PG8_LAS bf16x8*)(lds + PG8_SA(b, h) + aoff + m * 2048 + k * 1024); } while (0)
#define PG8_LDB(dst, b, h) do { _Pragma("unroll") for (int n = 0; n < 2; ++n) _Pragma("unroll") for (int k = 0; k < 2; ++k) dst[n][k] = *(const PG8_LAS bf16x8*)(lds + PG8_SB(b, h) + boff + n * 2048 + k * 1024); } while (0)
#define PG8_MMA(ai, bj, At, Bt) do { __builtin_amdgcn_s_setprio(1); _Pragma("unroll") for (int m = 0; m < 4; ++m) _Pragma("unroll") for (int n = 0; n < 2; ++n) _Pragma("unroll") for (int k = 0; k < 2; ++k) \
        acc[ai][bj][m][n] = __builtin_amdgcn_mfma_f32_16x16x32_bf16(Bt[n][k], At[m][k], acc[ai][bj][m][n], 0, 0, 0); __builtin_amdgcn_s_setprio(0); } while (0)
#define PG8_WAIT_V(n) asm volatile("s_waitcnt vmcnt(" #n ")" ::: "memory")
#define PG8_WAIT_L(n) asm volatile("s_waitcnt lgkmcnt(" #n ")" ::: "memory")
#define PG8_BAR __builtin_amdgcn_s_barrier()
#define PG8_SCHED __builtin_amdgcn_sched_barrier(0)
    Unit cur, nxt; int ui = 0;
    if (!S.next(0, cur)) return;
    f32x4 acc[2][2][4][2];
#pragma unroll
    for (int a = 0; a < 2; ++a)
#pragma unroll
        for (int b = 0; b < 2; ++b)
#pragma unroll
            for (int m = 0; m < 4; ++m)
#pragma unroll
                for (int n = 0; n < 2; ++n) acc[a][b][m][n] = (f32x4){0.f, 0.f, 0.f, 0.f};
    bf16x8 At[4][2], B0[2][2], B1[2][2];
    const char* cA = (const char*)g.A + (size_t)cur.pm * tstepA; const char* cB = (const char*)g.Bt + (size_t)cur.pn * tstepB;
    S.a_ready(cur);
    if constexpr (SP2) {
        PG8_STAGE(PG8_SB(0, 0), cB, voffB); PG8_STAGE(PG8_SB(0, 1), cB + hstepB, voffB); PG8_STAGE(PG8_SA(0, 0), cA, voffA); PG8_STAGE(PG8_SA(0, 1), cA + hstepA, voffA);
        if (wr == 1) PG8_BAR;
        PG8_WAIT_V(2); PG8_BAR;
        PG8_STAGE(PG8_SB(1, 0), cB + kstep, voffB); PG8_STAGE(PG8_SA(1, 0), cA + kstep, voffA); PG8_STAGE(PG8_SB(1, 1), cB + hstepB + kstep, voffB);
        PG8_WAIT_V(6); PG8_BAR;
    } else {
        PG8_STAGE(PG8_SB(0, 0), cB, voffB); PG8_STAGE(PG8_SA(0, 0), cA, voffA); PG8_STAGE(PG8_SB(0, 1), cB + hstepB, voffB); PG8_STAGE(PG8_SA(0, 1), cA + hstepA, voffA);
        if (wr == 1) PG8_BAR;
        PG8_WAIT_V(4); PG8_BAR;
        PG8_STAGE(PG8_SB(1, 0), cB + kstep, voffB); PG8_STAGE(PG8_SA(1, 0), cA + kstep, voffA); PG8_STAGE(PG8_SB(1, 1), cB + hstepB + kstep, voffB);
        PG8_WAIT_V(6); PG8_BAR;
    }
    for (;;) {
        const bool has_next = S.next(ui + 1, nxt);
        const char* nA = has_next ? (const char*)g.A + (size_t)nxt.pm * tstepA : cA; const char* nB = has_next ? (const char*)g.Bt + (size_t)nxt.pn * tstepB : cB;
        for (int t = 0; t < nt; t += 2) {
            const bool last = (t == nt - 2);
            const char* a1 = cA + (size_t)(t + 1) * kstep;
            const char* a2 = last ? nA : cA + (size_t)(t + 2) * kstep; const char* b2 = last ? nB : cB + (size_t)(t + 2) * kstep;
            const char* a3 = a2 + kstep; const char* b3 = b2 + kstep;
            if (last && has_next) S.a_ready(nxt);
            if constexpr (SP2) {
            PG8_LDB(B0, 0, 0); PG8_LDB(B1, 0, 1); PG8_SCHED; PG8_LDA(At, 0, 0); PG8_STAGE(PG8_SA(1, 1), a1 + hstepA, voffA);
            PG8_WAIT_V(8); PG8_WAIT_L(0); PG8_BAR; PG8_MMA(0, 0, At, B0); PG8_MMA(0, 1, At, B1); PG8_BAR; PG8_SCHED;
            PG8_LDA(At, 0, 1); PG8_STAGE(PG8_SB(0, 0), b2, voffB); PG8_STAGE(PG8_SB(0, 1), b2 + hstepB, voffB); PG8_STAGE(PG8_SA(0, 0), a2, voffA);
            PG8_WAIT_V(8); PG8_WAIT_L(0); PG8_BAR; PG8_MMA(1, 0, At, B0); PG8_MMA(1, 1, At, B1); PG8_BAR; PG8_SCHED;
            PG8_LDB(B0, 1, 0); PG8_LDB(B1, 1, 1); PG8_SCHED; PG8_LDA(At, 1, 0); PG8_STAGE(PG8_SA(0, 1), a2 + hstepA, voffA);
            PG8_WAIT_V(8); PG8_WAIT_L(0); PG8_BAR; PG8_MMA(0, 0, At, B0); PG8_MMA(0, 1, At, B1); PG8_BAR; PG8_SCHED;
            PG8_LDA(At, 1, 1); PG8_STAGE(PG8_SB(1, 0), b3, voffB); PG8_STAGE(PG8_SB(1, 1), b3 + hstepB, voffB); PG8_STAGE(PG8_SA(1, 0), a3, voffA);
            PG8_WAIT_V(8); PG8_WAIT_L(0); PG8_BAR; PG8_MMA(1, 0, At, B0); PG8_MMA(1, 1, At, B1); PG8_BAR; PG8_SCHED;
            } else {
            PG8_LDB(B0, 0, 0); PG8_SCHED; PG8_LDA(At, 0, 0); PG8_STAGE(PG8_SA(1, 1), a1 + hstepA, voffA);
            PG8_WAIT_L(8); PG8_BAR; PG8_WAIT_L(0); PG8_MMA(0, 0, At, B0); PG8_BAR; PG8_SCHED;
            PG8_LDB(B1, 0, 1); PG8_STAGE(PG8_SB(0, 0), b2, voffB);
            PG8_BAR; PG8_WAIT_L(0); PG8_MMA(0, 1, At, B1); PG8_BAR;
            PG8_LDA(At, 0, 1); PG8_STAGE(PG8_SA(0, 0), a2, voffA);
            PG8_BAR; PG8_WAIT_L(0); PG8_MMA(1, 0, At, B0); PG8_BAR; PG8_SCHED;
            PG8_STAGE(PG8_SB(0, 1), b2 + hstepB, voffB);
            PG8_WAIT_V(6); PG8_BAR; PG8_MMA(1, 1, At, B1); PG8_BAR;
            PG8_LDB(B0, 1, 0); PG8_SCHED; PG8_LDA(At, 1, 0); PG8_STAGE(PG8_SA(0, 1), a2 + hstepA, voffA);
            PG8_WAIT_L(8); PG8_BAR; PG8_WAIT_L(0); PG8_MMA(0, 0, At, B0); PG8_BAR; PG8_SCHED;
            PG8_LDB(B1, 1, 1); PG8_STAGE(PG8_SB(1, 0), b3, voffB);
            PG8_BAR; PG8_WAIT_L(0); PG8_MMA(0, 1, At, B1); PG8_BAR;
            PG8_LDA(At, 1, 1); PG8_STAGE(PG8_SA(1, 0), a3, voffA);
            PG8_BAR; PG8_WAIT_L(0); PG8_MMA(1, 0, At, B0); PG8_BAR; PG8_SCHED;
            PG8_STAGE(PG8_SB(1, 1), b3 + hstepB, voffB);
            PG8_WAIT_V(6); PG8_BAR; PG8_MMA(1, 1, At, B1); PG8_BAR;
            }
        }
        if constexpr (ALIGN_EPI) { if (wr == 0) PG8_BAR; }
        if constexpr (!Epi::AFTER_DRAIN) { E(acc, cur, wr, wc, fr, fq); S.done(cur); }
        if (!has_next) break;
#pragma unroll
        for (int a = 0; a < 2; ++a)
#pragma unroll
            for (int b = 0; b < 2; ++b)
#pragma unroll
                for (int m = 0; m < 4; ++m)
#pragma unroll
                    for (int n = 0; n < 2; ++n) acc[a][b][m][n] = (f32x4){0.f, 0.f, 0.f, 0.f};
        cur = nxt; cA = nA; cB = nB; ++ui;
        if constexpr (ALIGN_EPI) { if (wr == 1) PG8_BAR; }
    }
    PG8_WAIT_V(0);
    if constexpr (!ALIGN_EPI) { if (wr == 0) PG8_BAR; }
    PG8_BAR;
    if constexpr (Epi::AFTER_DRAIN) { E.fused(acc, cur, wr, wc, fr, fq, lds, wid, lane); S.done(cur); }
#undef PG8_SA
#undef PG8_SB
#undef PG8_STAGE
#undef PG8_LDA
#undef PG8_LDB
#undef PG8_MMA
#undef PG8_WAIT_V
#undef PG8_WAIT_L
#undef PG8_BAR
#undef PG8_SCHED
}
}
constexpr int NWAVES = 8;
constexpr int SEQ = 8192, BATCH = 2, M = BATCH * SEQ, D = 1024, DFF = 2816, NZ = 6912  , DIN_SRC = 6864;
constexpr float EPSN = 1e-6f;
constexpr float LOG2E = 1.4426950408889634f;
constexpr int ZC_CQ = 0, ZC_CKV = 256, ZC_KROPE = 384, ZC_GA = 416, ZC_XW = 432, ZC_GQ = 512, ZC_GK = 768, ZC_GV = 1024, ZC_GG = 1536,
              ZC_RR = 2048, ZC_RK = 2560, ZC_RV = 3072, ZC_XA = 3584, ZC_XG = 3648, ZC_GATE = 3840;
constexpr size_t MiB = 1u << 20;
constexpr size_t WS_CTL = 0, CTL_ZERO_BYTES = 1 * MiB;
constexpr size_t WS_CS = 1 * MiB;
constexpr size_t WS_RS = 3 * MiB;
constexpr size_t WS_MEMN = 4 * MiB;
constexpr size_t WS_MEMKV = 5 * MiB;
constexpr size_t WS_GDEC = 7 * MiB;
constexpr size_t WS_W = 8 * MiB;
constexpr size_t WS_XN = 70 * MiB;
constexpr size_t WS_Y = 102 * MiB;
constexpr size_t WS_ZH = 166 * MiB;
constexpr size_t WS_Q = 382 * MiB;
constexpr size_t WS_K = 406 * MiB;
constexpr size_t WS_V = 430 * MiB;
constexpr size_t WS_OABC = 446 * MiB;
constexpr size_t WS_GU = 494 * MiB;
constexpr size_t WS_GS = 526 * MiB;
constexpr size_t WS_RA = 542 * MiB;
constexpr size_t WS_RQ = 558 * MiB;
constexpr size_t WS_RSC = 574 * MiB;
constexpr size_t WS_E1 = 590 * MiB;
constexpr size_t WS_E2 = 606 * MiB;
constexpr size_t WS_END = 622 * MiB;
constexpr size_t W_FFN_IN0 = 0, W_FFN_IN1 = 5767168, W_FFN_OUT0 = 11534336, W_FFN_OUT1 = 14417920, W_IN = 17301504, W_UQ = 24379392, W_UKV = 24576000,
                 W_BR = 24707072, W_OUT = 26279936, W_MQ = 27328512, W_MKV = 28377088, W_MO = 30474240, W_TOTAL = 31522816;
constexpr int CW_TMO = 0, CW_CODE = 1, CW_BAR = 4096, CW_QUEUE = 8192;
constexpr int RING_OFF = 0;
constexpr int LDS_BYTES = 155648;
constexpr int MISC_OFF = 150 * 1024;

typedef short s16x4 __attribute__((ext_vector_type(4)));
typedef float f32x16 __attribute__((ext_vector_type(16)));
typedef float f32x2 __attribute__((ext_vector_type(2)));
typedef unsigned u32x2 __attribute__((ext_vector_type(2)));
typedef unsigned u32x4 __attribute__((ext_vector_type(4)));
typedef short v4i16_t __attribute__((ext_vector_type(4)));

__device__ __forceinline__ float bf2f(unsigned short b) { return __builtin_bit_cast(float, (unsigned)b << 16); }
__device__ __forceinline__ float bflo(unsigned w) { return __builtin_bit_cast(float, w << 16); }
__device__ __forceinline__ float bfhi(unsigned w) { return __builtin_bit_cast(float, w & 0xffff0000u); }
__device__ __forceinline__ float fast_exp2(float x) { return __builtin_amdgcn_exp2f(x); }
__device__ __forceinline__ float fast_rcp(float x) { return __builtin_amdgcn_rcpf(x); }
__device__ __forceinline__ float sigmoid_f(float x) { return fast_rcp(1.f + fast_exp2(-x * LOG2E)); }
__device__ __forceinline__ float silu_f(float x) { return x * sigmoid_f(x); }
__device__ __forceinline__ float softplus_nabs(float x) { return 0.6931471805599453f * __builtin_amdgcn_logf(1.f + fast_exp2(-fabsf(x) * LOG2E)); }
template <int K> __device__ __forceinline__ float swz_xor(float v) { static_assert(K == 1 || K == 2 || K == 4 || K == 8 || K == 16, "swizzle xor inside 32 lanes"); return __builtin_bit_cast(float, __builtin_amdgcn_ds_swizzle(__builtin_bit_cast(int, v), (K << 10) | 0x1f)); }
__device__ __forceinline__ float xor32_val(float v) { const unsigned x = __float_as_uint(v); auto rr = __builtin_amdgcn_permlane32_swap(x, x, false, false); return __uint_as_float(rr[0] ^ rr[1] ^ x); }
__device__ __forceinline__ float add_x16_x32(float s) { s += swz_xor<16>(s); s += xor32_val(s); return s; }
__device__ __forceinline__ float shfl_up_l(float v, int lane, int off) { const int src = lane >= off ? lane - off : lane; return __builtin_bit_cast(float, __builtin_amdgcn_ds_bpermute(src << 2, __builtin_bit_cast(int, v))); }
__device__ __forceinline__ float wave_sum(float v) { v += swz_xor<1>(v); v += swz_xor<2>(v); v += swz_xor<4>(v); v += swz_xor<8>(v); v += swz_xor<16>(v); v += xor32_val(v); return v; }
template <bool KS> __device__ __forceinline__ bf16x8 ldfrag(const LAS unsigned char* base, int pitch, int row0, int k0, int lane) {
    if constexpr (!KS) {
        return *(const LAS bf16x8*)(base + (row0 + (lane & 15)) * pitch + (k0 + 8 * (lane >> 4)) * 2);
    } else {
        const int g = lane >> 4, q = (lane & 15) >> 2, p = lane & 3;
        const LAS unsigned char* a = base + (k0 + 8 * g + q) * pitch + (row0 + 4 * p) * 2;
        const v4i16_t lo = __builtin_amdgcn_ds_read_tr16_b64_v4i16((LAS v4i16_t*)a);
        const v4i16_t hi = __builtin_amdgcn_ds_read_tr16_b64_v4i16((LAS v4i16_t*)(a + 4 * pitch));
        return (bf16x8){lo[0], lo[1], lo[2], lo[3], hi[0], hi[1], hi[2], hi[3]};
    }
}
template <bool MKS, bool NKS, int K> __device__ __forceinline__ void mm16(f32x4& acc, const LAS unsigned char* Mb, int mp, int mrow0, const LAS unsigned char* Nb, int np, int nrow0, int lane) {
#pragma unroll
    for (int k0 = 0; k0 < K; k0 += 32) acc = __builtin_amdgcn_mfma_f32_16x16x32_bf16(ldfrag<NKS>(Nb, np, nrow0, k0, lane), ldfrag<MKS>(Mb, mp, mrow0, k0, lane), acc, 0, 0, 0);
}
__device__ __forceinline__ bf16x8 gfrag(const bf16* base, int pitch_el, int row0, int k0, int lane) {
    return *(const bf16x8*)(base + (size_t)(row0 + (lane & 15)) * pitch_el + k0 + 8 * (lane >> 4));
}
__device__ __forceinline__ u32x2 pack4(f32x4 v) { u32x2 r; r.x = pk2(v[0], v[1]); r.y = pk2(v[2], v[3]); return r; }
__device__ __forceinline__ f32x4 unpack4(u32x2 w) { return (f32x4){bflo(w.x), bfhi(w.x), bflo(w.y), bfhi(w.y)}; }
#define WG_SYNC() __syncthreads()
typedef f32x4 AccT[2][2][4][2];
#define EPI_LAUNDER unsigned char* ws = wsb; asm volatile("" : "+s"(ws), "+s"(wr), "+s"(wc)); asm volatile("" : "+v"(fr), "+v"(fq));
using pg8::Unit;
#define EPI_ROWS_BEGIN _Pragma("unroll") for (int ai = 0; ai < 2; ++ai) _Pragma("unroll") for (int m = 0; m < 4; ++m) { const int row = u.pm * 256 + ai * 128 + wr * 64 + m * 16 + fr;
#define EPI_ROWS_END }
__device__ __forceinline__ u32x4 pack8(f32x4 a, f32x4 b) { u32x4 w; w.x = pg8::cvt_pk_bf16(a[0], a[1]); w.y = pg8::cvt_pk_bf16(a[2], a[3]); w.z = pg8::cvt_pk_bf16(b[0], b[1]); w.w = pg8::cvt_pk_bf16(b[2], b[3]); return w; }

struct EpiSwiglu {
    static constexpr bool PERM = true, AFTER_DRAIN = false;
    unsigned char* wsb;
    __device__ __forceinline__ void operator()(const AccT& acc, const Unit& u, int wr, int wc, int fr, int fq) const {
        EPI_LAUNDER
        bf16* H = (bf16*)(ws + WS_ZH); const int col = u.pn * 128 + wc * 32 + 8 * fq;
        EPI_ROWS_BEGIN
            f32x4 o[2];
#pragma unroll
            for (int n = 0; n < 2; ++n)
#pragma unroll
                for (int j = 0; j < 4; ++j) { const float g = acc[ai][0][m][n][j]; o[n][j] = silu_f(g) * acc[ai][1][m][n][j]; }
            *(u32x4*)(H + (size_t)row * DFF + col) = pack8(o[0], o[1]);
        EPI_ROWS_END
    }
};
struct EpiF32 {
    static constexpr bool PERM = false, AFTER_DRAIN = false;
    unsigned char* wsb;
    __device__ __forceinline__ void operator()(const AccT& acc, const Unit& u, int wr, int wc, int fr, int fq) const {
        EPI_LAUNDER
        float* Y = (float*)(ws + WS_Y); constexpr int ldc = D;
        EPI_ROWS_BEGIN
#pragma unroll
            for (int bj = 0; bj < 2; ++bj)
#pragma unroll
                for (int n = 0; n < 2; ++n) *(f32x4*)(Y + (size_t)row * ldc + u.pn * 256 + bj * 128 + wc * 32 + 16 * n + 4 * fq) = acc[ai][bj][m][n];
        EPI_ROWS_END
    }
};
template <int WHICH  > struct EpiBf16S {
    static constexpr bool PERM = true, AFTER_DRAIN = false;
    unsigned char* wsb;
    __device__ __forceinline__ void operator()(const AccT& acc, const Unit& u, int wr, int wc, int fr, int fq) const {
        EPI_LAUNDER
        bf16* O = (bf16*)(ws + (WHICH == 0 ? WS_MEMKV : WS_Q)); constexpr int ldc = WHICH == 0 ? 2 * D : D; const float scale = WHICH == 0 ? 1.f : 0.0625f * LOG2E;
        EPI_ROWS_BEGIN
#pragma unroll
            for (int bj = 0; bj < 2; ++bj)
                *(u32x4*)(O + (size_t)row * ldc + u.pn * 256 + bj * 128 + wc * 32 + 8 * fq) = pack8(acc[ai][bj][m][0] * scale, acc[ai][bj][m][1] * scale);
        EPI_ROWS_END
    }
};
struct EpiZ {
    static constexpr bool PERM = true, AFTER_DRAIN = false;
    unsigned char* wsb;
    __device__ __forceinline__ void operator()(const AccT& acc, const Unit& u, int wr, int wc, int fr, int fq) const {
        EPI_LAUNDER
        bf16* Z = (bf16*)(ws + WS_ZH); float* RS = (float*)(ws + WS_RS);
        EPI_ROWS_BEGIN
#pragma unroll
            for (int bj = 0; bj < 2; ++bj)
                *(u32x4*)(Z + (size_t)row * NZ + u.pn * 256 + bj * 128 + wc * 32 + 8 * fq) = pack8(acc[ai][bj][m][0], acc[ai][bj][m][1]);
            if (u.pn < 2) {
                float s = 0.f;
#pragma unroll
                for (int bj = 0; bj < 2; ++bj) if (u.pn == 0 || bj == 0)
#pragma unroll
                    for (int n = 0; n < 2; ++n) { const f32x4 v = acc[ai][bj][m][n]; s += (v[0] * v[0] + v[1] * v[1]) + (v[2] * v[2] + v[3] * v[3]); }
                s = add_x16_x32(s);
                if (fq == 0) RS[(size_t)row * 8 + u.pn * 4 + wc] = s;
            }
        EPI_ROWS_END
    }
};
struct EpiQ {
    static constexpr bool PERM = true, AFTER_DRAIN = false;
    unsigned char* wsb;
    __device__ __forceinline__ void operator()(const AccT& acc, const Unit& u, int wr, int wc, int fr, int fq) const {
        EPI_LAUNDER
        bf16* Q = (bf16*)(ws + WS_Q); const float* RS = (const float*)(ws + WS_RS);
        const float C2Q = 0.10206207261596577f * LOG2E;
        EPI_ROWS_BEGIN
            const f32x4 p = *(const f32x4*)(RS + (size_t)row * 8);
            const float sc = rsqrtf(((p[0] + p[1]) + (p[2] + p[3])) * (1.f / 256.f) + EPSN) * C2Q;
#pragma unroll
            for (int bj = 0; bj < 2; ++bj)
                *(u32x4*)(Q + (size_t)row * 768 + u.pn * 256 + bj * 128 + wc * 32 + 8 * fq) = pack8(acc[ai][bj][m][0] * sc, acc[ai][bj][m][1] * sc);
        EPI_ROWS_END
    }
};
struct EpiKV {
    static constexpr bool PERM = true, AFTER_DRAIN = false;
    unsigned char* wsb;
    __device__ __forceinline__ void operator()(const AccT& acc, const Unit& u, int wr, int wc, int fr, int fq) const {
        EPI_LAUNDER
        bf16* K = (bf16*)(ws + WS_K); bf16* V = (bf16*)(ws + WS_V); const float* RS = (const float*)(ws + WS_RS);
        EPI_ROWS_BEGIN
            const f32x4 p = *(const f32x4*)(RS + (size_t)row * 8 + 4);
            const float sc = rsqrtf(((p[0] + p[1]) + (p[2] + p[3])) * (1.f / 128.f) + EPSN);
#pragma unroll
            for (int bj = 0; bj < 2; ++bj) {
                const int head = u.pn * 2 + bj;
                const u32x4 w = pack8(acc[ai][bj][m][0] * sc, acc[ai][bj][m][1] * sc);
                if (wc < 2) *(u32x4*)(K + (size_t)row * 768 + head * 96 + wc * 32 + 8 * fq) = w;
                else *(u32x4*)(V + (size_t)row * 512 + head * 64 + (wc - 2) * 32 + 8 * fq) = w;
            }
        EPI_ROWS_END
    }
};
template <int MODE> struct EpiBranch {
    static constexpr bool PERM = true, AFTER_DRAIN = false;
    unsigned char* wsb;
    __device__ __forceinline__ void operator()(const AccT& acc, const Unit& u, int wr, int wc, int fr, int fq) const {
        EPI_LAUNDER
        const bf16* Z = (const bf16*)(ws + WS_ZH); float* Y = (float*)(ws + WS_Y); bf16* MG = (bf16*)(ws + WS_XN); constexpr int bi = MODE;
        EPI_ROWS_BEGIN
#pragma unroll
            for (int bj = 0; bj < 2; ++bj) {
                const int col = u.pn * 256 + bj * 128 + wc * 32 + 8 * fq;
                const u32x4 gw = *(const u32x4*)(Z + (size_t)row * NZ + ZC_GATE + bi * 1024 + col);
                f32x4 v0, v1;
                v0[0] = acc[ai][bj][m][0][0] * sigmoid_f(bflo(gw.x)); v0[1] = acc[ai][bj][m][0][1] * sigmoid_f(bfhi(gw.x));
                v0[2] = acc[ai][bj][m][0][2] * sigmoid_f(bflo(gw.y)); v0[3] = acc[ai][bj][m][0][3] * sigmoid_f(bfhi(gw.y));
                v1[0] = acc[ai][bj][m][1][0] * sigmoid_f(bflo(gw.z)); v1[1] = acc[ai][bj][m][1][1] * sigmoid_f(bfhi(gw.z));
                v1[2] = acc[ai][bj][m][1][2] * sigmoid_f(bflo(gw.w)); v1[3] = acc[ai][bj][m][1][3] * sigmoid_f(bfhi(gw.w));
                float* yp = Y + (size_t)row * D + col;
                if (MODE > 0) { v0 += *(const f32x4*)(yp); v1 += *(const f32x4*)(yp + 4); }
                if (MODE < 2) { *(f32x4*)(yp) = v0; *(f32x4*)(yp + 4) = v1; }
                else *(u32x4*)(MG + (size_t)row * D + col) = pack8(v0, v1);
            }
        EPI_ROWS_END
    }
};
namespace att {
__device__ __forceinline__ int crow(int r, int hi) { return (r & 3) + 8 * (r >> 2) + 4 * hi; }
__device__ __forceinline__ float pl32_max(float m) { auto rr = __builtin_amdgcn_permlane32_swap(__float_as_uint(m), __float_as_uint(m), false, false); return fmaxf(__uint_as_float(rr[0]), __uint_as_float(rr[1])); }
__device__ __forceinline__ float pl32_sum(float m) { auto rr = __builtin_amdgcn_permlane32_swap(__float_as_uint(m), __float_as_uint(m), false, false); return __uint_as_float(rr[0]) + __uint_as_float(rr[1]); }

template <int DK, int DV> struct Lay {
    static constexpr int KSLOT = DK * 128, VSLOT = DV * 128, K_OFF = 0, V_OFF = 2 * KSLOT, WS_OFF = V_OFF + 2 * VSLOT, BYTES = WS_OFF + 8 * 512;
    static_assert(8 * 32 * DV * 2 <= 2 * KSLOT + 2 * VSLOT, "O staging must fit in the K and V slots");
};
template <int DK, int DV, bool CAUSAL, bool ROPEQ>
__device__ __forceinline__ void attn_unit(const int w0, const float* CSq  , const bf16* Qp, int qpitch, const bf16* Kp, int kpitch, const bf16* Vp, int vpitch, bf16* Op, int opitch, int q0, int NT, LAS unsigned char* shm) {
    typedef Lay<DK, DV> L;
    constexpr int NKCH = DK / 8, NVBL = (DV / 32) * 4, ND = DK / 16, NO = DV / 32;
    const int tid = lt_tid(w0), lane = tid & 63, r32 = lane & 31, hi = lane >> 5;
    const int wid = __builtin_amdgcn_readfirstlane(tid >> 6);
    LAS float* wsf = (LAS float*)(shm + L::WS_OFF) + wid * 128;
#define ATT_ISSUE(t_, slot_) do { _Pragma("unroll") for (int i0 = 0; i0 < NKCH + NVBL; i0 += 8) { const int i = i0 + wid; \
        if (i < NKCH) { const bf16* src = Kp + (size_t)(64 * (t_) + lane) * kpitch + i * 8; \
            __builtin_amdgcn_global_load_lds((const unsigned*)src, (LAS unsigned*)(shm + L::K_OFF + (slot_) * L::KSLOT + i * 1024), 16, 0, 0); } \
        else if (i < NKCH + NVBL) { const int blk = i - NKCH, dh = blk >> 2, kg = blk & 3; \
            const bf16* src = Vp + (size_t)(64 * (t_) + 16 * kg + (lane >> 2)) * vpitch + dh * 32 + (lane & 3) * 8; \
            __builtin_amdgcn_global_load_lds((const unsigned*)src, (LAS unsigned*)(shm + L::V_OFF + (slot_) * L::VSLOT + blk * 1024), 16, 0, 0); } } } while (0)
    ATT_ISSUE(0, 0);
    bf16x8 qr[ND];
#pragma unroll
    for (int d0 = 0; d0 < ND; ++d0) qr[d0] = *(const bf16x8*)(Qp + (size_t)(wid * 32 + r32) * qpitch + d0 * 16 + hi * 8);
    if constexpr (ROPEQ) {
        const float* cs = CSq + (size_t)(wid * 32 + r32) * 32 + 16 * hi;
        const f32x4 c0 = *(const f32x4*)cs, c1 = *(const f32x4*)(cs + 4), c2 = *(const f32x4*)(cs + 8), c3 = *(const f32x4*)(cs + 12);
        const float cosv[8] = {c0[0], c0[2], c1[0], c1[2], c2[0], c2[2], c3[0], c3[2]}, sinv[8] = {c0[1], c0[3], c1[1], c1[3], c2[1], c2[3], c3[1], c3[3]};
        const u32x4 w1 = __builtin_bit_cast(u32x4, qr[ND - 2]), w2 = __builtin_bit_cast(u32x4, qr[ND - 1]); u32x4 o1, o2;
#pragma unroll
        for (int j = 0; j < 4; ++j) { const float a0 = bflo(w1[j]), a1 = bfhi(w1[j]), b0 = bflo(w2[j]), b1 = bfhi(w2[j]);
            o1[j] = pk2(a0 * cosv[2 * j] - b0 * sinv[2 * j], a1 * cosv[2 * j + 1] - b1 * sinv[2 * j + 1]);
            o2[j] = pk2(a0 * sinv[2 * j] + b0 * cosv[2 * j], a1 * sinv[2 * j + 1] + b1 * cosv[2 * j + 1]); }
        qr[ND - 2] = __builtin_bit_cast(bf16x8, o1); qr[ND - 1] = __builtin_bit_cast(bf16x8, o2);
    }
    f32x16 o[NO];
#pragma unroll
    for (int i = 0; i < NO; ++i) o[i] = f32x16{};
    float mrow = 0.f, lsum = 0.f;
    f32x16 negm = f32x16{}; asm volatile("" : "+v"(negm));
    const int qme = q0 + wid * 32 + r32, qmin_w = q0 + wid * 32, qmax_w = qmin_w + 31;
    asm volatile("s_waitcnt vmcnt(0)" ::: "memory");
    __syncthreads();
    constexpr float THR = 8.f;
    for (int t = 0; t < NT; ++t) {
        const int slot = t & 1;
        if (t + 1 < NT) ATT_ISSUE(t + 1, slot ^ 1);
        const bool active = !CAUSAL || (64 * t <= qmax_w);
        if (active) {
            const LAS unsigned char* kb = shm + L::K_OFF + slot * L::KSLOT + hi * 1024 + r32 * 16;
            f32x16 p0, p1;
#pragma unroll
            for (int d0 = 0; d0 < ND; ++d0) {
                const bf16x8 b0 = *(const LAS bf16x8*)(kb + d0 * 2048), b1 = *(const LAS bf16x8*)(kb + d0 * 2048 + 512);
                p0 = __builtin_amdgcn_mfma_f32_32x32x16_bf16(b0, qr[d0], d0 == 0 ? negm : p0, 0, 0, 0);
                p1 = __builtin_amdgcn_mfma_f32_32x32x16_bf16(b1, qr[d0], d0 == 0 ? negm : p1, 0, 0, 0);
            }
            if (CAUSAL && (64 * t + 63 > qmin_w)) {
#pragma unroll
                for (int r = 0; r < 16; ++r) { const int kv = 64 * t + crow(r, hi); if (kv > qme) p0[r] = -INFINITY; if (kv + 32 > qme) p1[r] = -INFINITY; }
            }
            float ra = fmaxf(fmaxf(p0[0], p0[1]), p1[0]), rb = fmaxf(fmaxf(p0[2], p0[3]), p1[1]);
            ra = fmaxf(fmaxf(ra, p1[2]), p1[3]);
#pragma unroll
            for (int r = 4; r < 16; r += 4) { ra = fmaxf(fmaxf(ra, p0[r]), p0[r + 1]); rb = fmaxf(fmaxf(rb, p0[r + 2]), p0[r + 3]); ra = fmaxf(fmaxf(ra, p1[r]), p1[r + 1]); rb = fmaxf(fmaxf(rb, p1[r + 2]), p1[r + 3]); }
            const float rm = pl32_max(fmaxf(ra, rb));
            if (t == 0 || __any(rm > THR)) {
                const float dl = (t == 0) ? rm : fmaxf(rm, 0.f), f = fast_exp2(-dl);
                mrow += dl; lsum *= f;
#pragma unroll
                for (int r = 0; r < 16; ++r) { p0[r] -= dl; p1[r] -= dl; negm[r] = -mrow; }
                asm volatile("" : "+v"(negm));
                if (t > 0) {
                    if (hi == 0) wsf[r32] = f;
                    asm volatile("s_waitcnt lgkmcnt(0)" ::: "memory");
#pragma unroll
                    for (int g = 0; g < 4; ++g) { const f32x4 fv = *(const LAS f32x4*)(wsf + 8 * g + 4 * hi);
#pragma unroll
                        for (int i = 0; i < NO; ++i) { o[i][4 * g + 0] *= fv[0]; o[i][4 * g + 1] *= fv[1]; o[i][4 * g + 2] *= fv[2]; o[i][4 * g + 3] *= fv[3]; } }
                }
            }
            f32x2 ls2 = {0.f, 0.f};
#pragma unroll
            for (int r = 0; r < 16; r += 2) { p0[r] = fast_exp2(p0[r]); p0[r + 1] = fast_exp2(p0[r + 1]); p1[r] = fast_exp2(p1[r]); p1[r + 1] = fast_exp2(p1[r + 1]);
                ls2 += (f32x2){p0[r], p0[r + 1]}; ls2 += (f32x2){p1[r], p1[r + 1]}; }
            lsum += ls2[0] + ls2[1];
            u32x4 pw[4];
#pragma unroll
            for (int j = 0; j < 4; ++j) { pw[0][j] = pk2(p0[2 * j], p0[2 * j + 1]); pw[1][j] = pk2(p0[8 + 2 * j], p0[8 + 2 * j + 1]); pw[2][j] = pk2(p1[2 * j], p1[2 * j + 1]); pw[3][j] = pk2(p1[8 + 2 * j], p1[8 + 2 * j + 1]); }
            const LAS unsigned char* vb = shm + L::V_OFF + slot * L::VSLOT + ((lane >> 4) & 1) * 32 + (lane & 3) * 8 + (4 * hi + ((lane & 15) >> 2)) * 64;
#pragma unroll
            for (int d0 = 0; d0 < NO; ++d0)
#pragma unroll
                for (int ks = 0; ks < 4; ++ks) {
                    const v4i16_t lo = __builtin_amdgcn_ds_read_tr16_b64_v4i16((LAS v4i16_t*)(vb + d0 * 4096 + ks * 1024));
                    const v4i16_t hv = __builtin_amdgcn_ds_read_tr16_b64_v4i16((LAS v4i16_t*)(vb + d0 * 4096 + ks * 1024 + 512));
                    const bf16x8 vf = (bf16x8){lo[0], lo[1], lo[2], lo[3], hv[0], hv[1], hv[2], hv[3]};
                    o[d0] = __builtin_amdgcn_mfma_f32_32x32x16_bf16(__builtin_bit_cast(bf16x8, pw[ks]), vf, o[d0], 0, 0, 0);
                }
        }
        asm volatile("s_waitcnt vmcnt(0) lgkmcnt(0)" ::: "memory");
        __syncthreads();
    }
    lsum = pl32_sum(lsum);
    if (hi == 0) wsf[64 + r32] = lsum;
    asm volatile("s_waitcnt lgkmcnt(0)" ::: "memory");
    LAS bf16* stg = (LAS bf16*)(shm + L::K_OFF) + wid * 32 * DV;
#pragma unroll
    for (int r = 0; r < 16; ++r) { const int orow = crow(r, hi); const float il = fast_rcp(wsf[64 + orow]);
#pragma unroll
        for (int d0 = 0; d0 < NO; ++d0) stg[orow * DV + d0 * 32 + r32] = (bf16)f2bf(o[d0][r] * il); }
    asm volatile("s_waitcnt lgkmcnt(0)" ::: "memory");
    constexpr int CPR = DV / 8;
#pragma unroll
    for (int i = 0; i < (32 * CPR) / 64; ++i) { const int idx = i * 64 + lane, row = idx / CPR, ch = idx % CPR;
        const u32x4 v = *(const LAS u32x4*)(stg + row * DV + ch * 8);
        *(u32x4*)(Op + (size_t)(wid * 32 + row) * opitch + ch * 8) = v; }
    asm volatile("s_waitcnt lgkmcnt(0)" ::: "memory");
    __syncthreads();
}
#undef ATT_ISSUE
}
namespace gla {
constexpr int P72 = 144, P136 = 272;
constexpr int L_G = 0;
constexpr int L_WA = 16640;
constexpr int L_A = 20992;
constexpr int L_B = 30208;
constexpr int L_SM = 39424;
constexpr int L_V = 48640;
constexpr int L_ST = 66048;
constexpr int L_PART = 83456;
struct Ptrs { const bf16* Z; const float* w_alpha; const float* b_alpha; const float* gnorm; float* GU; bf16* GS; float* GDEC; bf16* OABC; };

__device__ __forceinline__ void logdecay_cumsum(const Ptrs& P, LAS unsigned char* lds, int row0, int h, int tid, int lane, int wid) {
    LAS float* G = (LAS float*)(lds + L_G); LAS float* WA = (LAS float*)(lds + L_WA);
    for (int i = tid; i < 16 * 64 + 64; i += 512) WA[i] = (i < 1024) ? P.w_alpha[(i >> 6) * 256 + h * 64 + (i & 63)] : P.b_alpha[h * 64 + (i - 1024)];
    const int t = tid >> 3, d0 = (tid & 7) * 8;
    const u32x4 a0 = *(const u32x4*)(P.Z + (size_t)(row0 + t) * NZ + ZC_GA), a1 = *(const u32x4*)(P.Z + (size_t)(row0 + t) * NZ + ZC_GA + 8);
    const float av[16] = {bflo(a0.x), bfhi(a0.x), bflo(a0.y), bfhi(a0.y), bflo(a0.z), bfhi(a0.z), bflo(a0.w), bfhi(a0.w), bflo(a1.x), bfhi(a1.x), bflo(a1.y), bfhi(a1.y), bflo(a1.z), bfhi(a1.z), bflo(a1.w), bfhi(a1.w)};
    WG_SYNC();
#pragma unroll
    for (int j = 0; j < 8; ++j) { const int d = d0 + j; float x = WA[1024 + d];
#pragma unroll
        for (int k = 0; k < 16; ++k) x += av[k] * WA[k * 64 + d];
        const float ls = fminf(x, 0.f) - softplus_nabs(x);
        G[t * 65 + d] = ls * (1.f / 16.f); }
    WG_SYNC();
#pragma unroll
    for (int j = 0; j < 8; ++j) { const int d = wid * 8 + j; float v = G[lane * 65 + d];
#pragma unroll
        for (int off = 1; off < 64; off <<= 1) { const float n = shfl_up_l(v, lane, off); if (lane >= off) v += n; }
        G[lane * 65 + d] = v; }
    WG_SYNC();
}
__device__ __forceinline__ void gl1_unit(const int w0, const Ptrs& P, LAS unsigned char* lds, int unit) {
    const int tid = lt_tid(w0), lane = tid & 63, wid = __builtin_amdgcn_readfirstlane(tid >> 6);
    const int h = unit & 3, bc = unit >> 2, row0 = (bc >> 7) * SEQ + (bc & 127) * 64;
    logdecay_cumsum(P, lds, row0, h, tid, lane, wid);
    const LAS float* G = (const LAS float*)(lds + L_G);
    { const int t = tid >> 3, d0 = (tid & 7) * 8;
      const u32x4 kw = *(const u32x4*)(P.Z + (size_t)(row0 + t) * NZ + ZC_GK + h * 64 + d0);
      const float kv[8] = {bflo(kw.x), bfhi(kw.x), bflo(kw.y), bfhi(kw.y), bflo(kw.z), bfhi(kw.z), bflo(kw.w), bfhi(kw.w)};
      float o[8];
#pragma unroll
      for (int j = 0; j < 8; ++j) o[j] = kv[j] * __expf(G[63 * 65 + d0 + j] - G[t * 65 + d0 + j]);
      u32x4 w; w.x = pk2(o[0], o[1]); w.y = pk2(o[2], o[3]); w.z = pk2(o[4], o[5]); w.w = pk2(o[6], o[7]);
      *(LAS u32x4*)(lds + L_A + t * P72 + d0 * 2) = w;
      const int v0 = (tid & 7) * 16;
      const bf16* vp = P.Z + (size_t)(row0 + t) * NZ + ZC_GV + h * 128 + v0;
      *(LAS u32x4*)(lds + L_V + t * P136 + v0 * 2) = *(const u32x4*)vp; *(LAS u32x4*)(lds + L_V + t * P136 + v0 * 2 + 16) = *(const u32x4*)(vp + 8); }
    if (tid < 64) P.GDEC[(size_t)unit * 64 + tid] = __expf(G[63 * 65 + tid]);
    WG_SYNC();
    const int mb = wid & 3;
#pragma unroll
    for (int i = 0; i < 4; ++i) { const int nb = 4 * (wid >> 2) + i; f32x4 acc = {0.f, 0.f, 0.f, 0.f};
        mm16<true, true, 64>(acc, lds + L_A, P72, 16 * mb, lds + L_V, P136, 16 * nb, lane);
        *(f32x4*)(P.GU + ((size_t)unit * 64 + 16 * mb + (lane & 15)) * 128 + 16 * nb + 4 * (lane >> 4)) = acc; }
    WG_SYNC();
}
__device__ __forceinline__ void gl2_item(const int w0, const Ptrs& P, int item) {
    const int tid = lt_tid(w0), chain = item >> 2, b = chain >> 2, h = chain & 3, d = (item & 3) * 16 + (tid >> 5), v0 = (tid & 31) * 4;
    f32x4 s = {0.f, 0.f, 0.f, 0.f};
#pragma unroll 8
    for (int c = 0; c < 128; ++c) { const size_t unit = (size_t)(b * 128 + c) * 4 + h;
        *(u32x2*)(P.GS + (unit * 64 + d) * 128 + v0) = pack4(s);
        const f32x4 uu = *(const f32x4*)(P.GU + (unit * 64 + d) * 128 + v0); const float dec = P.GDEC[unit * 64 + d];
        s = s * dec + uu; }
}
__device__ __forceinline__ void gl3_unit(const int w0, const Ptrs& P, LAS unsigned char* lds, int unit) {
    const int tid = lt_tid(w0), lane = tid & 63, wid = __builtin_amdgcn_readfirstlane(tid >> 6);
    const int h = unit & 3, bc = unit >> 2, row0 = (bc >> 7) * SEQ + (bc & 127) * 64;
    logdecay_cumsum(P, lds, row0, h, tid, lane, wid);
    const LAS float* G = (const LAS float*)(lds + L_G);
    { const int t = tid >> 3, d0 = (tid & 7) * 8;
      const u32x4 qw = *(const u32x4*)(P.Z + (size_t)(row0 + t) * NZ + ZC_GQ + h * 64 + d0), kw = *(const u32x4*)(P.Z + (size_t)(row0 + t) * NZ + ZC_GK + h * 64 + d0);
      const float qv[8] = {bflo(qw.x), bfhi(qw.x), bflo(qw.y), bfhi(qw.y), bflo(qw.z), bfhi(qw.z), bflo(qw.w), bfhi(qw.w)};
      const float kv[8] = {bflo(kw.x), bfhi(kw.x), bflo(kw.y), bfhi(kw.y), bflo(kw.z), bfhi(kw.z), bflo(kw.w), bfhi(kw.w)};
      float qo[8], ko[8];
#pragma unroll
      for (int j = 0; j < 8; ++j) { const float bb = G[t * 65 + d0 + j]; qo[j] = qv[j] * 0.125f * __expf(bb); ko[j] = kv[j] * __expf(-bb); }
      u32x4 w; w.x = pk2(qo[0], qo[1]); w.y = pk2(qo[2], qo[3]); w.z = pk2(qo[4], qo[5]); w.w = pk2(qo[6], qo[7]);
      *(LAS u32x4*)(lds + L_A + t * P72 + d0 * 2) = w;
      w.x = pk2(ko[0], ko[1]); w.y = pk2(ko[2], ko[3]); w.z = pk2(ko[4], ko[5]); w.w = pk2(ko[6], ko[7]);
      *(LAS u32x4*)(lds + L_B + t * P72 + d0 * 2) = w;
      const int v0 = (tid & 7) * 16;
      const bf16* vp = P.Z + (size_t)(row0 + t) * NZ + ZC_GV + h * 128 + v0;
      *(LAS u32x4*)(lds + L_V + t * P136 + v0 * 2) = *(const u32x4*)vp; *(LAS u32x4*)(lds + L_V + t * P136 + v0 * 2 + 16) = *(const u32x4*)(vp + 8);
      const bf16* sp = P.GS + ((size_t)unit * 64 + t) * 128 + v0;
      *(LAS u32x4*)(lds + L_ST + t * P136 + v0 * 2) = *(const u32x4*)sp; *(LAS u32x4*)(lds + L_ST + t * P136 + v0 * 2 + 16) = *(const u32x4*)(sp + 8); }
    WG_SYNC();
    const int mb = wid & 3, tq = 16 * mb + (lane & 15);
#pragma unroll
    for (int i = 0; i < 2; ++i) { const int nb = 2 * (wid >> 2) + i; f32x4 acc = {0.f, 0.f, 0.f, 0.f};
        mm16<false, false, 64>(acc, lds + L_A, P72, 16 * mb, lds + L_B, P72, 16 * nb, lane);
#pragma unroll
        for (int r = 0; r < 4; ++r) if (16 * nb + 4 * (lane >> 4) + r > tq) acc[r] = 0.f;
        *(LAS u32x2*)(lds + L_SM + tq * P72 + (16 * nb + 4 * (lane >> 4)) * 2) = pack4(acc); }
    WG_SYNC();
    f32x4 acc[4]; float ssq = 0.f;
#pragma unroll
    for (int i = 0; i < 4; ++i) { const int nb = 4 * (wid >> 2) + i; acc[i] = (f32x4){0.f, 0.f, 0.f, 0.f};
        mm16<false, true, 64>(acc[i], lds + L_SM, P72, 16 * mb, lds + L_V, P136, 16 * nb, lane);
        mm16<false, true, 64>(acc[i], lds + L_A, P72, 16 * mb, lds + L_ST, P136, 16 * nb, lane);
        ssq += (acc[i][0] * acc[i][0] + acc[i][1] * acc[i][1]) + (acc[i][2] * acc[i][2] + acc[i][3] * acc[i][3]); }
    ssq = add_x16_x32(ssq);
    LAS float* PART = (LAS float*)(lds + L_PART);
    if ((lane >> 4) == 0) PART[tq * 2 + (wid >> 2)] = ssq;
    WG_SYNC();
    const float rs = rsqrtf((PART[tq * 2] + PART[tq * 2 + 1]) * (1.f / 128.f) + EPSN);
#pragma unroll
    for (int i = 0; i < 4; ++i) { const int v = 16 * (4 * (wid >> 2) + i) + 4 * (lane >> 4);
        const f32x4 gn = *(const f32x4*)(P.gnorm + v);
        const f32x4 gg = unpack4(*(const u32x2*)(P.Z + (size_t)(row0 + tq) * NZ + ZC_GG + h * 128 + v));
        f32x4 o;
#pragma unroll
        for (int r = 0; r < 4; ++r) o[r] = acc[i][r] * rs * gn[r] * silu_f(gg[r]);
        *(u32x2*)(P.OABC + (size_t)(row0 + tq) * 1536 + 512 + h * 128 + v) = pack4(o); }
    WG_SYNC();
}
}
namespace rwkv {
constexpr int P72 = 144, PSG = 336;
constexpr int A_TW = 0, A_XA = 9216, A_WD = 18432, A_WI = 27648;
constexpr int A_SG = 0, A_WG = 21504;
constexpr int A_G = 0;
constexpr int A_PP = 0, A_ARK = 9216, A_NARB = 18432, A_MM = 27648  , A_WM = 27648, A_UV = 36864, A_XF = 46080  ;
constexpr int S_KQ = 79872, S_KD = S_KQ + 9216, S_BD = S_KD + 9216, S_KE = S_BD + 9216, S_NBE = S_KE + 9216, S_RD = S_NBE + 9216, S_VV = S_RD + 9216;
constexpr int L_RED = S_VV + 9216  , L_BON = L_RED + 512  , L_EGC = L_BON + 512  , L_END = L_EGC + 256;
static_assert(L_END <= 150 * 1024, "rwkv LDS map");
struct Ptrs { const bf16* Z; const float *mu, *w0, *w_decay, *a0, *w_iclr, *w_gate, *k_k, *k_a, *r_k, *ln_w, *ln_b;
              bf16* RA; float* RB; bf16* RQ; float* RY0; bf16* RSC; bf16* E1; bf16* E2; bf16* OABC; };

__device__ __forceinline__ f32x4 ld4bf(const bf16* p) { return unpack4(*(const u32x2*)p); }
__device__ __forceinline__ f32x4 lerp4(const bf16* Z, size_t row, bool has_prev, int col, const float* mu) {
    const f32x4 z = ld4bf(Z + row * NZ + col); f32x4 zp = {0.f, 0.f, 0.f, 0.f};
    if (has_prev) zp = ld4bf(Z + (row - 1) * NZ + col);
    const f32x4 m = *(const f32x4*)mu;
    return z + m * (zp - z);
}
__device__ __forceinline__ void rw1_unit(const int w0, const Ptrs& P, LAS unsigned char* lds, int unit) {
    const int tid = lt_tid(w0), lane = tid & 63, wid = __builtin_amdgcn_readfirstlane(tid >> 6);
    const int h = unit & 7, bc = unit >> 3, c = bc & 127, row0 = (bc >> 7) * SEQ + c * 64;
    const int mb = wid & 3, nbp = wid >> 2, fr = lane & 15, fq = lane >> 4;
    const int t = 16 * mb + fr;
    const size_t row = (size_t)row0 + t; const bool has_prev = (c > 0) || (t > 0);
    f32x4 r_[2], k_[2], v_[2];
#pragma unroll
    for (int i = 0; i < 2; ++i) { const int j = 16 * (2 * nbp + i) + 4 * fq;
        r_[i] = lerp4(P.Z, row, has_prev, ZC_RR + h * 64 + j, P.mu + h * 64 + j);
        k_[i] = lerp4(P.Z, row, has_prev, ZC_RK + h * 64 + j, P.mu + 512 + h * 64 + j);
        v_[i] = lerp4(P.Z, row, has_prev, ZC_RV + h * 64 + j, P.mu + 1024 + h * 64 + j); }
#pragma unroll
    for (int i = 0; i < 2; ++i) { const int j = 16 * (2 * nbp + i) + 4 * fq;
        f32x4 xw = lerp4(P.Z, row, has_prev, ZC_XW + j, P.mu + 1536 + j);
#pragma unroll
        for (int q = 0; q < 4; ++q) { const float e = __expf(2.f * xw[q]); xw[q] = 1.f - 2.f / (e + 1.f); }
        *(LAS u32x2*)(lds + A_TW + t * P72 + j * 2) = pack4(xw);
        const f32x4 xa = lerp4(P.Z, row, has_prev, ZC_XA + j, P.mu + 1600 + j);
        *(LAS u32x2*)(lds + A_XA + t * P72 + j * 2) = pack4(xa); }
    { const int kr = tid >> 3, j0 = (tid & 7) * 8;
      const float* s1 = P.w_decay + (size_t)kr * 512 + h * 64 + j0; const float* s2 = P.w_iclr + (size_t)kr * 512 + h * 64 + j0;
      const f32x4 a = *(const f32x4*)s1, b = *(const f32x4*)(s1 + 4), c2 = *(const f32x4*)s2, d2 = *(const f32x4*)(s2 + 4);
      u32x4 w; w.x = pk2(a[0], a[1]); w.y = pk2(a[2], a[3]); w.z = pk2(b[0], b[1]); w.w = pk2(b[2], b[3]);
      *(LAS u32x4*)(lds + A_WD + kr * P72 + j0 * 2) = w;
      w.x = pk2(c2[0], c2[1]); w.y = pk2(c2[2], c2[3]); w.z = pk2(d2[0], d2[1]); w.w = pk2(d2[2], d2[3]);
      *(LAS u32x4*)(lds + A_WI + kr * P72 + j0 * 2) = w; }
    WG_SYNC();
    f32x4 wl[2], al[2], gg[2];
#pragma unroll
    for (int i = 0; i < 2; ++i) { const int nb = 2 * nbp + i; wl[i] = (f32x4){0.f, 0.f, 0.f, 0.f}; al[i] = (f32x4){0.f, 0.f, 0.f, 0.f}; gg[i] = (f32x4){0.f, 0.f, 0.f, 0.f};
        mm16<false, true, 64>(wl[i], lds + A_TW, P72, 16 * mb, lds + A_WD, P72, 16 * nb, lane);
        mm16<false, true, 64>(al[i], lds + A_XA, P72, 16 * mb, lds + A_WI, P72, 16 * nb, lane); }
    WG_SYNC();
    { const int tt = tid >> 3, c0 = (tid & 7) * 20; const size_t rr = (size_t)row0 + tt; const bool hp = (c > 0) || (tt > 0);
#pragma unroll
      for (int q = 0; q < 5; ++q) { f32x4 x = lerp4(P.Z, rr, hp, ZC_XG + c0 + 4 * q, P.mu + 1664 + c0 + 4 * q);
#pragma unroll
          for (int e = 0; e < 4; ++e) x[e] = sigmoid_f(x[e]);
          *(LAS u32x2*)(lds + A_SG + tt * PSG + (c0 + 4 * q) * 2) = pack4(x); } }
    for (int idx = tid; idx < 160 * 8; idx += 512) { const int kr = idx >> 3, j0 = (idx & 7) * 8;
        const float* s1 = P.w_gate + (size_t)kr * 512 + h * 64 + j0; const f32x4 a = *(const f32x4*)s1, b = *(const f32x4*)(s1 + 4);
        u32x4 w; w.x = pk2(a[0], a[1]); w.y = pk2(a[2], a[3]); w.z = pk2(b[0], b[1]); w.w = pk2(b[2], b[3]);
        *(LAS u32x4*)(lds + A_WG + kr * P72 + j0 * 2) = w; }
    WG_SYNC();
#pragma unroll
    for (int i = 0; i < 2; ++i) mm16<false, true, 160>(gg[i], lds + A_SG, PSG, 16 * mb, lds + A_WG, P72, 16 * (2 * nbp + i), lane);
    WG_SYNC();
    f32x4 lw[2], kk[2], km[2], bv[2]; float ssq = 0.f, bon = 0.f;
#pragma unroll
    for (int i = 0; i < 2; ++i) { const int j = 16 * (2 * nbp + i) + 4 * fq, cj = h * 64 + j;
        const f32x4 w0v = *(const f32x4*)(P.w0 + cj), a0v = *(const f32x4*)(P.a0 + cj), kkv = *(const f32x4*)(P.k_k + cj), kav = *(const f32x4*)(P.k_a + cj), rkv = *(const f32x4*)(P.r_k + cj);
#pragma unroll
        for (int q = 0; q < 4; ++q) {
            const float x = -(w0v[q] + wl[i][q]);
            const float sp = fmaxf(x, 0.f) + softplus_nabs(x);
            lw[i][q] = -__expf(-sp - 0.5f);
            const float a = sigmoid_f(a0v[q] + al[i][q]);
            const float kq = k_[i][q] * kkv[q];
            kk[i][q] = kq; ssq += kq * kq;
            km[i][q] = k_[i][q] * (1.f + (a - 1.f) * kav[q]);
            bv[i][q] = a;
            bon += r_[i][q] * km[i][q] * rkv[q]; } }
    ssq = add_x16_x32(ssq); bon = add_x16_x32(bon);
    LAS float* RED = (LAS float*)(lds + L_RED); LAS float* BON = (LAS float*)(lds + L_BON); LAS float* G = (LAS float*)(lds + A_G); LAS float* EGC = (LAS float*)(lds + L_EGC);
    if (fq == 0) { RED[t * 2 + nbp] = ssq; BON[t * 2 + nbp] = bon; }
#pragma unroll
    for (int i = 0; i < 2; ++i) { const int j = 16 * (2 * nbp + i) + 4 * fq;
#pragma unroll
        for (int q = 0; q < 4; ++q) G[t * 65 + j + q] = lw[i][q]; }
    WG_SYNC();
#pragma unroll
    for (int jj = 0; jj < 8; ++jj) { const int d = wid * 8 + jj; float v = G[lane * 65 + d];
#pragma unroll
        for (int off = 1; off < 64; off <<= 1) { const float n = shfl_up_l(v, lane, off); if (lane >= off) v += n; }
        G[lane * 65 + d] = v; }
    WG_SYNC();
    const float inorm = 1.f / fmaxf(sqrtf(RED[t * 2] + RED[t * 2 + 1]), 1e-12f), bonus = BON[t * 2] + BON[t * 2 + 1];
    f32x4 kqf[2], rdf[2];
#pragma unroll
    for (int i = 0; i < 2; ++i) { const int j = 16 * (2 * nbp + i) + 4 * fq;
        f32x4 kd, bd, ke, nbe;
#pragma unroll
        for (int q = 0; q < 4; ++q) {
            const float gt = G[t * 65 + j + q], gp = (t > 0) ? G[(t - 1) * 65 + j + q] : 0.f, gc = G[63 * 65 + j + q];
            const float kkn = kk[i][q] * inorm, bb = kkn * bv[i][q];
            const float eg = __expf(gt), egm = __expf(-gt), egc = __expf(gc - gt);
            kqf[i][q] = kkn * __expf(gp); rdf[i][q] = r_[i][q] * eg;
            kd[q] = km[i][q] * egm; bd[q] = bb * egm; ke[q] = km[i][q] * egc; nbe[q] = -bb * egc;
            if (t == 63) EGC[j + q] = eg; }
        const int off = t * P72 + j * 2;
        *(LAS u32x2*)(lds + S_KQ + off) = pack4(kqf[i]); *(LAS u32x2*)(lds + S_KD + off) = pack4(kd); *(LAS u32x2*)(lds + S_BD + off) = pack4(bd);
        *(LAS u32x2*)(lds + S_KE + off) = pack4(ke); *(LAS u32x2*)(lds + S_NBE + off) = pack4(nbe); *(LAS u32x2*)(lds + S_RD + off) = pack4(rdf[i]);
        *(LAS u32x2*)(lds + S_VV + off) = pack4(v_[i]);
        *(u32x2*)(P.E1 + row * 512 + h * 64 + j) = pack4(gg[i]);
        *(u32x2*)(P.E2 + row * 512 + h * 64 + j) = pack4(v_[i] * bonus); }
    WG_SYNC();
#pragma unroll
    for (int i = 0; i < 2; ++i) { const int nb = 2 * nbp + i, s0 = 16 * nb + 4 * fq;
        f32x4 pp = {0.f, 0.f, 0.f, 0.f}, mmv = pp, ark = pp, arb = pp;
        mm16<false, false, 64>(pp, lds + S_KQ, P72, 16 * mb, lds + S_KD, P72, 16 * nb, lane);
        mm16<false, false, 64>(mmv, lds + S_KQ, P72, 16 * mb, lds + S_BD, P72, 16 * nb, lane);
        mm16<false, false, 64>(ark, lds + S_RD, P72, 16 * mb, lds + S_KD, P72, 16 * nb, lane);
        mm16<false, false, 64>(arb, lds + S_RD, P72, 16 * mb, lds + S_BD, P72, 16 * nb, lane);
#pragma unroll
        for (int q = 0; q < 4; ++q) { const int s = s0 + q; if (s >= t) { pp[q] = 0.f; mmv[q] = 0.f; } if (s > t) { ark[q] = 0.f; arb[q] = 0.f; } arb[q] = -arb[q]; }
        *(LAS u32x2*)(lds + A_PP + t * P72 + s0 * 2) = pack4(pp); *(LAS u32x2*)(lds + A_ARK + t * P72 + s0 * 2) = pack4(ark); *(LAS u32x2*)(lds + A_NARB + t * P72 + s0 * 2) = pack4(arb);
        *(LAS f32x4*)(lds + A_MM + (t * 68 + s0) * 4) = mmv; }
    WG_SYNC();
#pragma unroll
    for (int i = 0; i < 2; ++i) { const int nb = 2 * nbp + i, j = 16 * nb + 4 * fq; f32x4 pv = {0.f, 0.f, 0.f, 0.f};
        mm16<false, true, 64>(pv, lds + A_PP, P72, 16 * mb, lds + S_VV, P72, 16 * nb, lane);
        *(LAS f32x4*)(lds + A_XF + (t * 132 + j) * 4) = kqf[i]; *(LAS f32x4*)(lds + A_XF + (t * 132 + 64 + j) * 4) = pv; }
    WG_SYNC();
    if (tid < 128) {
        float x[64];
#pragma unroll
        for (int tt = 0; tt < 64; ++tt) {
            float a = *(const LAS float*)(lds + A_XF + (tt * 132 + tid) * 4);
#pragma unroll
            for (int s4 = 0; s4 < tt; s4 += 4) { const f32x4 mv = *(const LAS f32x4*)(lds + A_MM + (tt * 68 + s4) * 4);
#pragma unroll
                for (int e = 0; e < 4; ++e) if (s4 + e < tt) a -= mv[e] * x[s4 + e]; }
            x[tt] = a;
            *(LAS float*)(lds + A_XF + (tt * 132 + tid) * 4) = a; }
    }
    WG_SYNC();
    { f32x4 wmv[2], uvv[2];
#pragma unroll
      for (int i = 0; i < 2; ++i) { const int j = 16 * (2 * nbp + i) + 4 * fq; wmv[i] = *(const LAS f32x4*)(lds + A_XF + (t * 132 + j) * 4); uvv[i] = *(const LAS f32x4*)(lds + A_XF + (t * 132 + 64 + j) * 4); }
#pragma unroll
      for (int i = 0; i < 2; ++i) { const int j = 16 * (2 * nbp + i) + 4 * fq;
          *(LAS u32x2*)(lds + A_WM + t * P72 + j * 2) = pack4(wmv[i]); *(LAS u32x2*)(lds + A_UV + t * P72 + j * 2) = pack4(uvv[i]); } }
    WG_SYNC();
    const size_t ub = (size_t)unit * 4096;
#pragma unroll
    for (int i = 0; i < 2; ++i) { const int nb = 2 * nbp + i, n0 = 16 * nb + 4 * fq, mrow = 16 * mb + fr;
        f32x4 at, bc2 = {0.f, 0.f, 0.f, 0.f}, rq = rdf[i], y0 = {0.f, 0.f, 0.f, 0.f};
#pragma unroll
        for (int q = 0; q < 4; ++q) at[q] = (n0 + q == mrow) ? EGC[mrow] : 0.f;
        mm16<true, true, 64>(at, lds + S_NBE, P72, 16 * mb, lds + A_WM, P72, 16 * nb, lane);
        mm16<true, true, 64>(bc2, lds + S_VV, P72, 16 * mb, lds + S_KE, P72, 16 * nb, lane);
        mm16<true, true, 64>(bc2, lds + A_UV, P72, 16 * mb, lds + S_NBE, P72, 16 * nb, lane);
        mm16<false, true, 64>(rq, lds + A_NARB, P72, 16 * mb, lds + A_WM, P72, 16 * nb, lane);
        mm16<false, true, 64>(y0, lds + A_ARK, P72, 16 * mb, lds + S_VV, P72, 16 * nb, lane);
        mm16<false, true, 64>(y0, lds + A_NARB, P72, 16 * mb, lds + A_UV, P72, 16 * nb, lane);
        *(u32x2*)(P.RA + ub + mrow * 64 + n0) = pack4(at); *(f32x4*)(P.RB + ub + mrow * 64 + n0) = bc2;
        *(u32x2*)(P.RQ + ub + mrow * 64 + n0) = pack4(rq); *(f32x4*)(P.RY0 + ub + mrow * 64 + n0) = y0; }
    WG_SYNC();
}
__device__ __forceinline__ void rw2_chain(const int w0, const Ptrs& P, LAS unsigned char* lds, int chain) {
    constexpr int PD = 4;
    const int tid = lt_tid(w0), lane = tid & 63, wid = __builtin_amdgcn_readfirstlane(tid >> 6);
    const int b = chain >> 3, h = chain & 7, mb = wid & 3, nbp = wid >> 2, fr = lane & 15, fq = lane >> 4, mrow = 16 * mb + fr;
    f32x4 S[2] = {{0.f, 0.f, 0.f, 0.f}, {0.f, 0.f, 0.f, 0.f}};
    bf16x8 af[PD][2][2]; f32x4 bb[PD][2];
#define RW2_LOAD(slot, c_) do { const size_t ub_ = ((size_t)(b * 128 + (c_)) * 8 + h) * 4096; _Pragma("unroll") for (int i = 0; i < 2; ++i) { const int nb = 2 * nbp + i; \
        af[slot][i][0] = gfrag(P.RA + ub_, 64, 16 * nb, 0, lane); af[slot][i][1] = gfrag(P.RA + ub_, 64, 16 * nb, 32, lane); bb[slot][i] = *(const f32x4*)(P.RB + ub_ + mrow * 64 + 16 * nb + 4 * fq); } } while (0)
#pragma unroll
    for (int j = 0; j < PD; ++j) RW2_LOAD(j, j);
    for (int c0 = 0; c0 < 128; c0 += PD) {
#pragma unroll
        for (int j = 0; j < PD; ++j) { const int c = c0 + j;
            const size_t ub = ((size_t)(b * 128 + c) * 8 + h) * 4096;
            LAS unsigned char* sl = lds + (c & 1) * 9216;
#pragma unroll
            for (int i = 0; i < 2; ++i) { const int n0 = 16 * (2 * nbp + i) + 4 * fq; const u32x2 w = pack4(S[i]);
                *(u32x2*)(P.RSC + ub + mrow * 64 + n0) = w; *(LAS u32x2*)(sl + mrow * P72 + n0 * 2) = w; }
            WG_SYNC();
#pragma unroll
            for (int i = 0; i < 2; ++i) { f32x4 acc = bb[j][i];
#pragma unroll
                for (int ks = 0; ks < 2; ++ks) acc = __builtin_amdgcn_mfma_f32_16x16x32_bf16(af[j][i][ks], ldfrag<false>(sl, P72, 16 * mb, 32 * ks, lane), acc, 0, 0, 0);
                S[i] = acc; }
            if (c + PD < 128) RW2_LOAD(j, c + PD);
        }
    }
#undef RW2_LOAD
    WG_SYNC();
}
__device__ __forceinline__ void rw3_unit(const int w0, const Ptrs& P, int unit) {
    const int lane = lt_tid(w0) & 63, fr = lane & 15, fq = lane >> 4;
    const int h = unit & 7, bc = unit >> 3, row0 = (bc >> 7) * SEQ + (bc & 127) * 64;
    const size_t ub = (size_t)unit * 4096;
    bf16x8 sf[4][2];
#pragma unroll
    for (int nb = 0; nb < 4; ++nb) { sf[nb][0] = gfrag(P.RSC + ub, 64, 16 * nb, 0, lane); sf[nb][1] = gfrag(P.RSC + ub, 64, 16 * nb, 32, lane); }
#pragma unroll
    for (int mb = 0; mb < 4; ++mb) {
        const bf16x8 q0 = gfrag(P.RQ + ub, 64, 16 * mb, 0, lane), q1 = gfrag(P.RQ + ub, 64, 16 * mb, 32, lane);
        const int t = 16 * mb + fr; const size_t row = (size_t)row0 + t;
        f32x4 y[4]; float s = 0.f;
#pragma unroll
        for (int nb = 0; nb < 4; ++nb) { y[nb] = *(const f32x4*)(P.RY0 + ub + t * 64 + 16 * nb + 4 * fq);
            y[nb] = __builtin_amdgcn_mfma_f32_16x16x32_bf16(sf[nb][0], q0, y[nb], 0, 0, 0); y[nb] = __builtin_amdgcn_mfma_f32_16x16x32_bf16(sf[nb][1], q1, y[nb], 0, 0, 0);
            s += (y[nb][0] + y[nb][1]) + (y[nb][2] + y[nb][3]); }
        s = add_x16_x32(s);
        const float mean = s * (1.f / 64.f); float v2 = 0.f;
#pragma unroll
        for (int nb = 0; nb < 4; ++nb) { y[nb] = y[nb] - mean; v2 += (y[nb][0] * y[nb][0] + y[nb][1] * y[nb][1]) + (y[nb][2] * y[nb][2] + y[nb][3] * y[nb][3]); }
        v2 = add_x16_x32(v2);
        const float rstd = rsqrtf(v2 * (1.f / 64.f) + 64e-5f);
#pragma unroll
        for (int nb = 0; nb < 4; ++nb) { const int i0 = 16 * nb + 4 * fq, ci = h * 64 + i0;
            const f32x4 lw = *(const f32x4*)(P.ln_w + ci), lb = *(const f32x4*)(P.ln_b + ci), e1 = ld4bf(P.E1 + row * 512 + ci), e2 = ld4bf(P.E2 + row * 512 + ci);
            const f32x4 o = (y[nb] * rstd * lw + lb + e2) * e1;
            *(u32x2*)(P.OABC + row * 1536 + 1024 + ci) = pack4(o); }
    }
}
}
#ifdef DBL_ATT
#define ATT_REP 2
#else
#define ATT_REP 1
#endif
#ifdef DBL_MEMATT
#define MEMATT_REP 2
#else
#define MEMATT_REP 1
#endif
#ifdef DBL_CONV
#define CONV_REP 2
#else
#define CONV_REP 1
#endif
#ifdef DBL_FFN
#define FFN_REP 2
#else
#define FFN_REP 1
#endif
#ifdef DBL_RW1
#define RW1_REP 2
#else
#define RW1_REP 1
#endif
struct Frame {
    LAS unsigned char* lds; gu32* ctl; unsigned char* ws;
    int tid, lane, wave, vcu, G;
    float* x;
};
__device__ __forceinline__ int zmap(int n) {
    if (n < 416) return n;
    if (n < 432) return 1952 + (n - 416);
    if (n < 496) return 3504 + (n - 432);
    if (n < 512) return -1;
    if (n < 768) return 416 + (n - 512);
    if (n < 1024) return 672 + (n - 768);
    if (n < 1536) return 928 + (n - 1024);
    if (n < 2048) return 1440 + (n - 1536);
    if (n < 3584) return 1968 + (n - 2048);
    if (n < 3648) return 3568 + (n - 3584);
    if (n < 3808) return 3632 + (n - 3648);
    if (n < 3840) return -1;
    return 3792 + (n - 3840);
}
struct MapId { __device__ __forceinline__ int operator()(int n) const { return n; } };
struct MapSwiglu { __device__ __forceinline__ int operator()(int n) const { const int tile = n >> 8, j = n & 255; return j < 128 ? 128 * tile + j : DFF + 128 * tile + (j - 128); } };
struct MapZ { __device__ __forceinline__ int operator()(int n) const { return zmap(n); } };
template <class Map> __device__ __forceinline__ void conv_matrix(Frame& F, const float* W, int K, int Nsrc, bf16* WT, int Ndst, int ldk, const float* kscale, Map map) {
    LAS float* scr = (LAS float*)(F.lds + RING_OFF + F.wave * 16384);
    const int gw = F.vcu * NWAVES + F.wave, NGW = F.G * NWAVES, nblk = Ndst / 32, items = (K / 64) * nblk, lane = F.lane;
    for (int it = gw; it < items; it += NGW) {
        const int kb = it / nblk, nb = it % nblk, k0 = 64 * kb, n0 = 32 * nb;
        const int sc = map(n0 + (lane & 31));
#pragma unroll 8
        for (int i = 0; i < 32; ++i) { const int kk = 2 * i + (lane >> 5); float v = 0.f;
            if (sc >= 0) { v = W[(size_t)(k0 + kk) * Nsrc + sc]; if (kscale) v *= kscale[k0 + kk]; }
            scr[kk * 33 + (lane & 31)] = v; }
        LDS_WAIT(); asm volatile("" ::: "memory");
        const int c = lane & 7;
#pragma unroll
        for (int j = 0; j < 4; ++j) { const int n = (lane >> 3) + 8 * j; const LAS float* s = scr + (8 * c) * 33 + n;
            v4u o; o.x = pk2(s[0 * 33], s[1 * 33]); o.y = pk2(s[2 * 33], s[3 * 33]); o.z = pk2(s[4 * 33], s[5 * 33]); o.w = pk2(s[6 * 33], s[7 * 33]);
            *(GAS v4u*)(WT + (size_t)(n0 + n) * ldk + k0 + 8 * c) = o; }
        LDS_WAIT(); asm volatile("" ::: "memory");
    }
}
struct In {
    const float *x, *mem; const int* pos; const float *norm_g, *w_ffn_in, *w_ffn_out, *w_in, *mla_q_norm, *mla_w_uq, *mla_kv_norm, *mla_w_ukv, *gla_w_alpha, *gla_b_alpha, *gla_norm,
        *rwkv_mu, *rwkv_w0, *rwkv_w_decay, *rwkv_a0, *rwkv_w_iclr, *rwkv_w_gate, *rwkv_k_k, *rwkv_k_a, *rwkv_r_k, *rwkv_ln_w, *rwkv_ln_b, *w_branch, *w_out, *mem_norm, *mem_wq, *mem_wkv, *mem_wo;
};
__device__ __forceinline__ float row_ssq(const f32x4 (&v)[4]) { float s = 0.f;
#pragma unroll
    for (int j = 0; j < 4; ++j) s += (v[j][0] * v[j][0] + v[j][1] * v[j][1]) + (v[j][2] * v[j][2] + v[j][3] * v[j][3]);
    return wave_sum(s); }
__device__ __forceinline__ void store_row_bf16(bf16* orow, const f32x4 (&v)[4], float rs, const f32x4 (&g)[4], int lane) {
    GAS unsigned long long* o8 = (GAS unsigned long long*)orow + lane;
#pragma unroll
    for (int j = 0; j < 4; ++j) o8[64 * j] = (unsigned long long)pk2(v[j][0] * rs * g[j][0], v[j][1] * rs * g[j][1]) | ((unsigned long long)pk2(v[j][2] * rs * g[j][2], v[j][3] * rs * g[j][3]) << 32);
}
__device__ __forceinline__ void norm_phase(Frame& F, const float* xin, const float* Y, float alpha, const float* g_post, const float* g_pre, bf16* XN) {
    const int gw = F.vcu * NWAVES + F.wave, NGW = F.G * NWAVES, lane = F.lane;
    f32x4 gp[4], gq[4];
#pragma unroll
    for (int j = 0; j < 4; ++j) { gp[j] = Y ? *(const f32x4*)(g_post + 4 * lane + 256 * j) : (f32x4){0.f, 0.f, 0.f, 0.f}; gq[j] = g_pre ? *(const f32x4*)(g_pre + 4 * lane + 256 * j) : (f32x4){0.f, 0.f, 0.f, 0.f}; }
    for (int m = gw; m < M; m += NGW) {
        f32x4 xv[4];
        const float* xr = (Y ? F.x : xin) + (size_t)m * D;
#pragma unroll
        for (int j = 0; j < 4; ++j) xv[j] = *(const f32x4*)(xr + 4 * lane + 256 * j);
        if (Y) { f32x4 yv[4];
#pragma unroll
            for (int j = 0; j < 4; ++j) yv[j] = *(const f32x4*)(Y + (size_t)m * D + 4 * lane + 256 * j);
            const float rs = rsqrtf(row_ssq(yv) * (1.f / D) + EPSN) * alpha;
#pragma unroll
            for (int j = 0; j < 4; ++j) xv[j] += yv[j] * rs * gp[j]; }
#pragma unroll
        for (int j = 0; j < 4; ++j) *(f32x4*)(F.x + (size_t)m * D + 4 * lane + 256 * j) = xv[j];
        if (g_pre) { const float rs2 = rsqrtf(row_ssq(xv) * (1.f / D) + EPSN); store_row_bf16(XN + (size_t)m * D, xv, rs2, gq, lane); }
    }
}
__device__ __forceinline__ void rope_table(Frame& F, const int* pos, float* CS) {
    const double inv_freq[16] = {1.0, 0.5623413251903491, 0.31622776601683794, 0.1778279410038923, 0.1, 0.05623413251903491, 0.031622776601683794, 0.01778279410038923,
                                 0.01, 0.005623413251903491, 0.0031622776601683794, 0.001778279410038923, 0.001, 0.0005623413251903491, 0.00031622776601683794, 0.0001778279410038923};
    for (int idx = F.vcu * 512 + F.tid; idx < M * 16; idx += F.G * 512) { const int i = idx & 15, r = idx >> 4;
        double dinv = inv_freq[0];
#pragma unroll
        for (int q = 1; q < 16; ++q) dinv = (i == q) ? inv_freq[q] : dinv;
        const double rev = (double)pos[r] * dinv * 0.15915494309189535;
        const float fr = (float)(rev - floor(rev));
        CS[idx * 2] = __builtin_amdgcn_cosf(fr); CS[idx * 2 + 1] = __builtin_amdgcn_sinf(fr); }
}
__device__ __forceinline__ const float* ldptr(const LAS unsigned long long* PT, int k) { const unsigned long long v = PT[k];
    const unsigned lo = __builtin_amdgcn_readfirstlane((unsigned)v), hi = __builtin_amdgcn_readfirstlane((unsigned)(v >> 32)); return (const float*)(((unsigned long long)hi << 32) | lo); }
#define PHASE_PTRS F.tid = lt_tid(w0); F.lane = F.tid & 63; F.wave = __builtin_amdgcn_readfirstlane(F.tid >> 6); unsigned char* ws = args.ws; asm volatile("" : "+s"(ws)); F.x = args.out; asm volatile("" : "+s"(F.x)); \
            bf16* W = (bf16*)(ws + WS_W); bf16* XN = (bf16*)(ws + WS_XN); float* Y = (float*)(ws + WS_Y); bf16* Z = (bf16*)(ws + WS_ZH); bf16* H = (bf16*)(ws + WS_ZH); \
            bf16* Qm = (bf16*)(ws + WS_Q); bf16* Km = (bf16*)(ws + WS_K); bf16* Vm = (bf16*)(ws + WS_V); bf16* OABC = (bf16*)(ws + WS_OABC); bf16* MQ = (bf16*)(ws + WS_Q); bf16* MO = (bf16*)(ws + WS_OABC); \
            float* RS = (float*)(ws + WS_RS); float* CS = (float*)(ws + WS_CS); bf16* MEMN = (bf16*)(ws + WS_MEMN); bf16* MEMKV = (bf16*)(ws + WS_MEMKV); \
            (void)W; (void)XN; (void)Y; (void)Z; (void)H; (void)Qm; (void)Km; (void)Vm; (void)OABC; (void)MQ; (void)MO; (void)RS; (void)CS; (void)MEMN; (void)MEMKV;
__device__ __forceinline__ bool ph_in(int lo, int hi, int k) { asm volatile("" : "+s"(lo), "+s"(hi)); return lo <= k && k < hi; }
struct Args { const void* in[31]; float* out; unsigned char* ws; int s_lo, s_hi, ph_lo, ph_hi, use_bar, pad; };

__global__ void __launch_bounds__(NWAVES * 64, 2) mk_fwd(Args args) {
    extern __shared__ __attribute__((aligned(16))) unsigned char lds_raw[];
    Frame F;
    F.lds = (LAS unsigned char*)lds_raw; F.ws = args.ws; F.ctl = (gu32*)(args.ws + WS_CTL);
    int w0 = __builtin_amdgcn_readfirstlane((int)threadIdx.x >> 6); asm volatile("" : "+s"(w0));
    F.tid = lt_tid(w0); F.lane = F.tid & 63; F.wave = w0;
    F.G = gridDim.x; { const int bx = blockIdx.x; F.vcu = (F.G % 8 == 0) ? (bx % 8) * (F.G / 8) + bx / 8 : bx; }
    F.x = nullptr;
    for (int u = F.tid; u < (LDS_BYTES - MISC_OFF) / 4; u += NWAVES * 64) ((LAS unsigned*)(F.lds + MISC_OFF))[u] = 0u;
    __syncthreads();
    LAS unsigned long long* PT = (LAS unsigned long long*)(F.lds + MISC_OFF + 256);
    if (F.tid == 0) {
#pragma unroll
        for (int k = 0; k < 31; ++k) PT[k] = (unsigned long long)args.in[k]; }
    __syncthreads();
    XcdBarrier bar; bar.bar = (unsigned*)(F.ctl + CW_BAR); bar.x = 0; bar.st = nullptr;
    if (args.use_bar) bar = xcd_barrier_post((unsigned*)(F.ctl + CW_BAR), (volatile LAS unsigned*)(F.lds + MISC_OFF) + 8);
#define GRID_BAR() do { if (args.use_bar) { XcdBarrier b2_ = bar; asm volatile("" : "+s"(b2_.bar)); xcd_barrier(b2_); } } while (0)
#define PH(k) ph_in(args.ph_lo, args.ph_hi, (k))
    for (int s = args.s_lo; s < args.s_hi; ++s) {
        const int l = s >> 1, f = s & 1;
#define NG (ldptr(PT, 3) + (size_t)l * 8 * D)
        if (f == 0 && PH(0)) { PHASE_PTRS

            for (int rep_ = 0; rep_ < CONV_REP; ++rep_) for (int ff = 0; ff < 2; ++ff) {
                conv_matrix(F, ldptr(PT, 4) + ((size_t)l * 2 + ff) * D * 2 * DFF, D, 2 * DFF, W + (ff ? W_FFN_IN1 : W_FFN_IN0), 2 * DFF, D, nullptr, MapSwiglu());
                conv_matrix(F, ldptr(PT, 5) + ((size_t)l * 2 + ff) * DFF * D, DFF, D, W + (ff ? W_FFN_OUT1 : W_FFN_OUT0), D, DFF, nullptr, MapId());
            }
            conv_matrix(F, ldptr(PT, 6) + (size_t)l * D * DIN_SRC, D, DIN_SRC, W + W_IN, NZ, D, nullptr, MapZ());
            conv_matrix(F, ldptr(PT, 8) + (size_t)l * 256 * 768, 256, 768, W + W_UQ, 768, 256, ldptr(PT, 7) + l * 256, MapId());
            conv_matrix(F, ldptr(PT, 10) + (size_t)l * 128 * 1024, 128, 1024, W + W_UKV, 1024, 128, ldptr(PT, 9) + l * 128, MapId());
            for (int bi = 0; bi < 3; ++bi) conv_matrix(F, ldptr(PT, 25) + ((size_t)l * 1536 + bi * 512) * D, 512, D, W + W_BR + (size_t)bi * 512 * D, D, 512, nullptr, MapId());
            conv_matrix(F, ldptr(PT, 26) + (size_t)l * D * D, D, D, W + W_OUT, D, D, nullptr, MapId());
            conv_matrix(F, ldptr(PT, 28) + (size_t)l * D * D, D, D, W + W_MQ, D, D, nullptr, MapId());
            conv_matrix(F, ldptr(PT, 29) + (size_t)l * D * 2 * D, D, 2 * D, W + W_MKV, 2 * D, D, nullptr, MapId());
            conv_matrix(F, ldptr(PT, 30) + (size_t)l * D * D, D, D, W + W_MO, D, D, nullptr, MapId());
            { f32x4 gq[4];
#pragma unroll
              for (int j = 0; j < 4; ++j) gq[j] = *(const f32x4*)(ldptr(PT, 27) + (size_t)l * D + 4 * F.lane + 256 * j);
              for (int m = F.vcu * NWAVES + F.wave; m < 512; m += F.G * NWAVES) { f32x4 v[4];
#pragma unroll
                  for (int j = 0; j < 4; ++j) v[j] = *(const f32x4*)(ldptr(PT, 1) + (size_t)m * D + 4 * F.lane + 256 * j);
                  store_row_bf16(MEMN + (size_t)m * D, v, rsqrtf(row_ssq(v) * (1.f / D) + EPSN), gq, F.lane); } }
            if (l == 0) { rope_table(F, (const int*)ldptr(PT, 2), CS); norm_phase(F, ldptr(PT, 0), nullptr, 0.f, nullptr, NG, XN); }
            GRID_BAR();
        }
        if (PH(1)) { PHASE_PTRS

            for (int rep_ = 0; rep_ < FFN_REP; ++rep_) { pg8::Gemm g{XN, W + (f ? W_FFN_IN1 : W_FFN_IN0), M, 2 * DFF, D, D, D}; pg8::StaticOrder S; S.init(M, 2 * DFF, F.G, (int)blockIdx.x);
              EpiSwiglu E{ws};
#ifndef SKIP_G1
pg8::gemm_phase<EpiSwiglu, pg8::StaticOrder, true, true>(w0, F.lds + RING_OFF, g, S, E);
#endif
 }
            if (f == 0) { pg8::Gemm g{MEMN, W + W_MKV, 512, 2 * D, D, D, D}; pg8::StaticOrder S; S.init(512, 2 * D, F.G, (int)blockIdx.x);
              EpiBf16S<0> E{ws};
#ifndef SKIP_G2
pg8::gemm_phase<EpiBf16S<0>, pg8::StaticOrder, true, true>(w0, F.lds + RING_OFF, g, S, E);
#endif
 }
            GRID_BAR();
        }
        if (PH(2)) { PHASE_PTRS

            pg8::Gemm g{H, W + (f ? W_FFN_OUT1 : W_FFN_OUT0), M, D, DFF, DFF, DFF}; pg8::StaticOrder S; S.init(M, D, F.G, (int)blockIdx.x);
            EpiF32 E{ws};
#ifndef SKIP_G3
pg8::gemm_phase<EpiF32, pg8::StaticOrder, true, true>(w0, F.lds + RING_OFF, g, S, E);
#endif

            GRID_BAR();
        }
        if (PH(3)) { PHASE_PTRS

            const float* g_pre = (f == 0) ? NG + 2 * D : (l < 3 ? NG + 8 * D : nullptr);
            norm_phase(F, nullptr, Y, 0.5f, NG + (f ? 7 : 1) * D, g_pre, XN);
            GRID_BAR();
        }
        if (f == 0) {
            if (PH(4)) { PHASE_PTRS

                pg8::Gemm g{XN, W + W_IN, M, NZ, D, D, D}; pg8::StaticOrder S; S.init(M, NZ, F.G, (int)blockIdx.x);
                EpiZ E{ws};
#ifndef SKIP_G4
pg8::gemm_phase<EpiZ, pg8::StaticOrder, true, true>(w0, F.lds + RING_OFF, g, S, E);
#endif

                GRID_BAR();
            }
            if (PH(5)) { PHASE_PTRS

                { pg8::Gemm g{Z + ZC_CQ, W + W_UQ, M, 768, 256, NZ, 256}; pg8::StaticOrder S; S.init(M, 768, F.G, (int)blockIdx.x);
                  EpiQ E{ws};
#ifndef SKIP_G5
pg8::gemm_phase<EpiQ, pg8::StaticOrder, true, true>(w0, F.lds + RING_OFF, g, S, E);
#endif
 }
                { pg8::Gemm g{Z + ZC_CKV, W + W_UKV, M, 1024, 128, NZ, 128}; pg8::StaticOrder S; S.init(M, 1024, F.G, (int)blockIdx.x);
                  EpiKV E{ws};
#ifndef SKIP_G6
pg8::gemm_phase<EpiKV, pg8::StaticOrder, true, true>(w0, F.lds + RING_OFF, g, S, E);
#endif
 }
            }
            if (PH(5)) { PHASE_PTRS
                for (int idx = F.vcu * 512 + F.tid; idx < M * 16; idx += F.G * 512) { const int i = idx & 15, r = idx >> 4;
                    const float t1 = bf2f(Z[(size_t)r * NZ + ZC_KROPE + i]), t2 = bf2f(Z[(size_t)r * NZ + ZC_KROPE + 16 + i]), c = CS[idx * 2], sn = CS[idx * 2 + 1];
                    const bf16 o1 = (bf16)f2bf(t1 * c - t2 * sn), o2 = (bf16)f2bf(t1 * sn + t2 * c);
#pragma unroll
                    for (int hh = 0; hh < 8; ++hh) { Km[(size_t)r * 768 + hh * 96 + 64 + i] = o1; Km[(size_t)r * 768 + hh * 96 + 80 + i] = o2; } }
                __syncthreads();
                rwkv::Ptrs RP{Z, ldptr(PT, 14) + l * 1824, ldptr(PT, 15) + l * 512, ldptr(PT, 16) + (size_t)l * 64 * 512, ldptr(PT, 17) + l * 512, ldptr(PT, 18) + (size_t)l * 64 * 512, ldptr(PT, 19) + (size_t)l * 160 * 512,
                           ldptr(PT, 20) + l * 512, ldptr(PT, 21) + l * 512, ldptr(PT, 22) + l * 512, ldptr(PT, 23) + l * 512, ldptr(PT, 24) + l * 512,
                           (bf16*)(ws + WS_RA), (float*)(ws + WS_Y), (bf16*)(ws + WS_RQ), (float*)(ws + WS_Y + 32 * MiB), (bf16*)(ws + WS_RSC), (bf16*)(ws + WS_E1), (bf16*)(ws + WS_E2), OABC};
                gla::Ptrs GP{Z, ldptr(PT, 11) + (size_t)l * 16 * 256, ldptr(PT, 12) + l * 256, ldptr(PT, 13) + l * 128, (float*)(ws + WS_GU), (bf16*)(ws + WS_GS), (float*)(ws + WS_GDEC), OABC};
#ifndef SKIP_RW1
                for (int u = F.vcu; u < 2048 * RW1_REP; u += F.G) rwkv::rw1_unit(w0, RP, F.lds, u & 2047);
#endif
#ifndef SKIP_GL1
                for (int u = F.vcu; u < 1024; u += F.G) gla::gl1_unit(w0, GP, F.lds, u);
#ifdef DBL_GL
                for (int u = F.vcu; u < 1024; u += F.G) gla::gl1_unit(w0, GP, F.lds, u);
#endif
#endif
                GRID_BAR();
            }
            if (PH(6)) { PHASE_PTRS

                rwkv::Ptrs RP{Z, ldptr(PT, 14) + l * 1824, ldptr(PT, 15) + l * 512, ldptr(PT, 16) + (size_t)l * 64 * 512, ldptr(PT, 17) + l * 512, ldptr(PT, 18) + (size_t)l * 64 * 512, ldptr(PT, 19) + (size_t)l * 160 * 512,
                           ldptr(PT, 20) + l * 512, ldptr(PT, 21) + l * 512, ldptr(PT, 22) + l * 512, ldptr(PT, 23) + l * 512, ldptr(PT, 24) + l * 512,
                           (bf16*)(ws + WS_RA), (float*)(ws + WS_Y), (bf16*)(ws + WS_RQ), (float*)(ws + WS_Y + 32 * MiB), (bf16*)(ws + WS_RSC), (bf16*)(ws + WS_E1), (bf16*)(ws + WS_E2), OABC};
                gla::Ptrs GP{Z, ldptr(PT, 11) + (size_t)l * 16 * 256, ldptr(PT, 12) + l * 256, ldptr(PT, 13) + l * 128, (float*)(ws + WS_GU), (bf16*)(ws + WS_GS), (float*)(ws + WS_GDEC), OABC};
#ifndef SKIP_RW2
                for (int ch = F.vcu; ch < 16; ch += F.G) rwkv::rw2_chain(w0, RP, F.lds, ch);
#ifdef DBL_RW2
                for (int ch = F.vcu; ch < 16; ch += F.G) rwkv::rw2_chain(w0, RP, F.lds, ch);
#endif
#endif
#ifndef SKIP_GL2
                for (int it = F.G - 1 - F.vcu; it < 32; it += F.G) gla::gl2_item(w0, GP, it);
#endif
                __syncthreads();
                { gu32* qctr = F.ctl + CW_QUEUE + 64 * s; LAS unsigned* qslot = (LAS unsigned*)(F.lds + MISC_OFF + 64);
                  for (;;) {
                      if (F.tid == 0) qslot[0] = __hip_atomic_fetch_add(qctr, 1u, __ATOMIC_RELAXED, __HIP_MEMORY_SCOPE_AGENT);
                      __syncthreads();
                      const int u = (int)qslot[0];
                      __syncthreads();
                      if (u >= 512 * ATT_REP) break;
                      const int uu = u & 511, qb = 31 - (uu >> 4), bh = uu & 15, b = bh >> 3, h = bh & 7; const size_t rb = (size_t)b * SEQ;
                      att::attn_unit<96, 64, true, true>(w0, CS + (rb + qb * 256) * 32, Qm + (rb + qb * 256) * 768 + h * 96, 768, Km + rb * 768 + h * 96, 768, Vm + rb * 512 + h * 64, 512, OABC + (rb + qb * 256) * 1536 + h * 64, 1536, qb * 256, (qb + 1) * 4, F.lds);
                  } }
                GRID_BAR();
            }
            if (PH(7)) { PHASE_PTRS

                rwkv::Ptrs RP{Z, ldptr(PT, 14) + l * 1824, ldptr(PT, 15) + l * 512, ldptr(PT, 16) + (size_t)l * 64 * 512, ldptr(PT, 17) + l * 512, ldptr(PT, 18) + (size_t)l * 64 * 512, ldptr(PT, 19) + (size_t)l * 160 * 512,
                           ldptr(PT, 20) + l * 512, ldptr(PT, 21) + l * 512, ldptr(PT, 22) + l * 512, ldptr(PT, 23) + l * 512, ldptr(PT, 24) + l * 512,
                           (bf16*)(ws + WS_RA), (float*)(ws + WS_Y), (bf16*)(ws + WS_RQ), (float*)(ws + WS_Y + 32 * MiB), (bf16*)(ws + WS_RSC), (bf16*)(ws + WS_E1), (bf16*)(ws + WS_E2), OABC};
                gla::Ptrs GP{Z, ldptr(PT, 11) + (size_t)l * 16 * 256, ldptr(PT, 12) + l * 256, ldptr(PT, 13) + l * 128, (float*)(ws + WS_GU), (bf16*)(ws + WS_GS), (float*)(ws + WS_GDEC), OABC};
#ifndef SKIP_RW3
                for (int u = F.vcu; u < 256; u += F.G) rwkv::rw3_unit(w0, RP, u * 8 + F.wave);
#ifdef DBL_RW3
                for (int u = F.vcu; u < 256; u += F.G) rwkv::rw3_unit(w0, RP, u * 8 + F.wave);
#endif
#endif
#ifndef SKIP_GL3
                for (int u = F.vcu; u < 1024; u += F.G) gla::gl3_unit(w0, GP, F.lds, u);
#ifdef DBL_GL
                for (int u = F.vcu; u < 1024; u += F.G) gla::gl3_unit(w0, GP, F.lds, u);
#endif
#endif
                GRID_BAR();
            }
            if (PH(8)) { PHASE_PTRS

                { pg8::Gemm g{OABC, W + W_BR, M, D, 512, 1536, 512}; pg8::StaticOrder S; S.init(M, D, F.G, (int)blockIdx.x);
                  EpiBranch<0> E{ws};
#ifndef SKIP_G7
pg8::gemm_phase<EpiBranch<0>, pg8::StaticOrder, true, true>(w0, F.lds + RING_OFF, g, S, E);
#endif
 }
                VM_WAIT(); __builtin_amdgcn_fence(__ATOMIC_ACQUIRE, "agent"); VM_WAIT(); __syncthreads();
                { pg8::Gemm g{OABC + 512, W + W_BR + (size_t)512 * D, M, D, 512, 1536, 512}; pg8::StaticOrder S; S.init(M, D, F.G, (int)blockIdx.x);
                  EpiBranch<1> E{ws};
#ifndef SKIP_G8
pg8::gemm_phase<EpiBranch<1>, pg8::StaticOrder, true, true>(w0, F.lds + RING_OFF, g, S, E);
#endif
 }
                VM_WAIT(); __builtin_amdgcn_fence(__ATOMIC_ACQUIRE, "agent"); VM_WAIT(); __syncthreads();
                { pg8::Gemm g{OABC + 1024, W + W_BR + (size_t)1024 * D, M, D, 512, 1536, 512}; pg8::StaticOrder S; S.init(M, D, F.G, (int)blockIdx.x);
                  EpiBranch<2> E{ws};
#ifndef SKIP_G9
pg8::gemm_phase<EpiBranch<2>, pg8::StaticOrder, true, true>(w0, F.lds + RING_OFF, g, S, E);
#endif
 }
                GRID_BAR();
            }
            if (PH(9)) { PHASE_PTRS

                pg8::Gemm g{XN, W + W_OUT, M, D, D, D, D}; pg8::StaticOrder S; S.init(M, D, F.G, (int)blockIdx.x);
                EpiF32 E{ws};
#ifndef SKIP_G10
pg8::gemm_phase<EpiF32, pg8::StaticOrder, true, true>(w0, F.lds + RING_OFF, g, S, E);
#endif

                GRID_BAR();
            }
            if (PH(10)) { PHASE_PTRS
 norm_phase(F, nullptr, Y, 1.0f, NG + 3 * D, NG + 4 * D, XN); GRID_BAR(); }
            if (PH(11)) { PHASE_PTRS

                pg8::Gemm g{XN, W + W_MQ, M, D, D, D, D}; pg8::StaticOrder S; S.init(M, D, F.G, (int)blockIdx.x);
                EpiBf16S<1> E{ws};
#ifndef SKIP_G11
pg8::gemm_phase<EpiBf16S<1>, pg8::StaticOrder, true, true>(w0, F.lds + RING_OFF, g, S, E);
#endif

                GRID_BAR();
            }
            if (PH(12)) { PHASE_PTRS

                for (int rep_ = 0; rep_ < MEMATT_REP; ++rep_) for (int u = F.vcu; u < 512; u += F.G) { const int rt = u >> 3, h = (u >> 1) & 3, dvh = u & 1, b = rt >> 5;
#ifndef SKIP_MEMATT
                    att::attn_unit<256, 128, false, false>(w0, nullptr, MQ + (size_t)rt * 256 * D + h * 256, D, MEMKV + (size_t)b * 256 * 2 * D + h * 256, 2 * D, MEMKV + (size_t)b * 256 * 2 * D + D + h * 256 + dvh * 128, 2 * D,
                                                    MO + (size_t)rt * 256 * D + h * 256 + dvh * 128, D, 0, 4, F.lds);
#endif
 }
                GRID_BAR();
            }
            if (PH(13)) { PHASE_PTRS

                pg8::Gemm g{MO, W + W_MO, M, D, D, D, D}; pg8::StaticOrder S; S.init(M, D, F.G, (int)blockIdx.x);
                EpiF32 E{ws};
#ifndef SKIP_G12
pg8::gemm_phase<EpiF32, pg8::StaticOrder, true, true>(w0, F.lds + RING_OFF, g, S, E);
#endif

                GRID_BAR();
            }
            if (PH(14)) { PHASE_PTRS
 norm_phase(F, nullptr, Y, 1.0f, NG + 5 * D, NG + 6 * D, XN); GRID_BAR(); }
        }
    }
#undef PH
#undef NG
#undef GRID_BAR
}


static void launch_mk(Args a, int grid, hipStream_t stream, int s_lo, int s_hi, int ph_lo, int ph_hi, int use_bar) {
    a.s_lo = s_lo; a.s_hi = s_hi; a.ph_lo = ph_lo; a.ph_hi = ph_hi; a.use_bar = use_bar; a.pad = 0;
    hipLaunchKernelGGL(mk_fwd, dim3(grid), dim3(NWAVES * 64), LDS_BYTES, stream, a);
}

extern "C" void kernel_launch(void* const* d_in, const int* in_sizes, int n_in, void* d_out, int out_size, void* d_ws, size_t ws_size, hipStream_t stream) {
    static int grid = 0;
    if (grid == 0) {
        if (n_in != 31 || out_size != M * D || ws_size < WS_END) { fprintf(stderr, "kernel_launch: unexpected problem shape (n_in %d, out %d, ws %zu)\n", n_in, out_size, ws_size); grid = -1; return; }
        int dev = 0, cus = 0;
        if (hipGetDevice(&dev) != hipSuccess || hipDeviceGetAttribute(&cus, hipDeviceAttributeMultiprocessorCount, dev) != hipSuccess) { grid = -1; return; }
        if (hipFuncSetAttribute((const void*)mk_fwd, hipFuncAttributeMaxDynamicSharedMemorySize, LDS_BYTES) != hipSuccess) { fprintf(stderr, "kernel_launch: hipFuncSetAttribute failed\n"); grid = -1; return; }
        int per_cu = 0;
        if (hipOccupancyMaxActiveBlocksPerMultiprocessor(&per_cu, (const void*)mk_fwd, NWAVES * 64, LDS_BYTES) != hipSuccess || per_cu < 1) fprintf(stderr, "kernel_launch: occupancy query reports %d\n", per_cu);
        (void)hipGetLastError();
        grid = cus;
    }
    if (grid < 0) return;
    (void)in_sizes;
    if (hipMemsetAsync((char*)d_ws + WS_CTL, 0, CTL_ZERO_BYTES, stream) != hipSuccess) return;
    Args a{};
    for (int i = 0; i < 31; ++i) a.in[i] = d_in[i];
    a.out = (float*)d_out; a.ws = (unsigned char*)d_ws;
#if defined(MK_DEBUG)
    Dbg dbg{(float*)((unsigned*)d_ws + SIG_WORDS), stream};
    unsigned char* ws = (unsigned char*)d_ws;
    typedef unsigned short u16;
    for (int s = 0; s < 2; ++s) for (int p = (s == 0 ? 0 : 1); p < (s == 0 ? 15 : 4); ++p) {
        launch_mk(a, grid, stream, s, s + 1, p, p + 1, 0);
        if (s == 0) switch (p) {
            case 0: sig_t<u16>(dbg, 1, 0, (const u16*)(ws + WS_XN), 8192, 1024, 1024, 0, 1.f); break;
            case 1: sig_t<u16>(dbg, 1, 1, (const u16*)(ws + WS_ZH), 8192, 2816, 2816, 0, 1.f); sig_t<u16>(dbg, 1, 19, (const u16*)(ws + WS_MEMKV), 256, 2048, 2048, 0, 1.f); break;
            case 3: sig_t<float>(dbg, 1, 2, (const float*)d_out, 8192, 1024, 1024, 0, 1.f); break;
            case 4: sig_t<u16>(dbg, 1, 3, (const u16*)(ws + WS_ZH), 8192, NZ, NZ, 1, 1.f); sig_t<float>(dbg, 1, 20, (const float*)(ws + WS_RS), 8192, 8, 8, 0, 1.f); break;
            case 5: sig_t<u16>(dbg, 1, 21, (const u16*)(ws + WS_Q), 8192, 768, 768, 7, 1.f / (0.10206207261596577f * LOG2E));
                    sig_t<u16>(dbg, 1, 5, (const u16*)(ws + WS_K), 8192, 768, 768, 2, 1.f); sig_t<u16>(dbg, 1, 6, (const u16*)(ws + WS_V), 8192, 512, 512, 4, 1.f);
                    sig_t<u16>(dbg, 1, 7, (const u16*)(ws + WS_K), 8192, 768, 768, 3, 1.f); sig_t<u16>(dbg, 1, 17, (const u16*)(ws + WS_E1), 8192, 512, 512, 0, 1.f); break;
            case 6: sig_t<u16>(dbg, 1, 8, (const u16*)(ws + WS_OABC), 8192, 512, 1536, 0, 1.f); break;
            case 7: sig_t<u16>(dbg, 1, 9, (const u16*)(ws + WS_OABC) + 512, 8192, 512, 1536, 0, 1.f); sig_t<u16>(dbg, 1, 10, (const u16*)(ws + WS_OABC) + 1024, 8192, 512, 1536, 0, 1.f); break;
            case 8: sig_t<u16>(dbg, 1, 11, (const u16*)(ws + WS_XN), 8192, 1024, 1024, 0, 1.f); break;
            case 10: sig_t<float>(dbg, 1, 12, (const float*)d_out, 8192, 1024, 1024, 0, 1.f); break;
            case 11: sig_t<u16>(dbg, 1, 13, (const u16*)(ws + WS_Q), 8192, 1024, 1024, 0, 1.f / (0.0625f * LOG2E)); break;
            case 12: sig_t<u16>(dbg, 1, 14, (const u16*)(ws + WS_OABC), 8192, 1024, 1024, 0, 1.f); break;
            case 14: sig_t<float>(dbg, 1, 15, (const float*)d_out, 8192, 1024, 1024, 0, 1.f); break;
            default: break;
        }
        if (s == 1 && p == 3) sig_t<float>(dbg, 1, 16, (const float*)d_out, 8192, 1024, 1024, 0, 1.f);
    }
    hipMemcpyAsync(d_out, d_in[0], (size_t)out_size * sizeof(float), hipMemcpyDeviceToDevice, stream);
    nv::forward(d_in, (float*)d_out, (float*)((char*)d_ws + 1 * MiB), stream, &dbg);
    hipLaunchKernelGGL(k_decide, dim3(1024), dim3(256), 0, stream, dbg.sig, (float*)d_out, out_size, 2e-3f);
#elif defined(MK_MULTI)
    for (int s = 0; s < 8; ++s) for (int p = ((s & 1) ? 1 : 0); p < ((s & 1) ? 4 : 15); ++p) launch_mk(a, grid, stream, s, s + 1, p, p + 1, 0);
#else
    launch_mk(a, grid, stream, 0, 8, 0, 15, 1);
#endif
}
```
